# Optimizing an MI355X kernel written in HIP

```python
import math
import jax, jax.numpy as jnp
from jax import lax
import numpy as np

D_MODEL = 1024
BATCH = 4
SEQ = 8192
DEPTH = 1

NSA_HEADS = 8
NSA_KV_GROUPS = 2
NSA_HEAD_DIM = 64
NSA_REP = NSA_HEADS // NSA_KV_GROUPS
N_BRANCH = 3
CMP_BLOCK = 32
CMP_STRIDE = 16
CMP_HIDDEN = 256
SLC_BLOCK = 64
SLC_TOPK = 16
WINDOW = 512
Q_BLOCK = 128
RET_HEADS = 4
RET_HEAD_DIM = 128
RET_CHUNK = 128
ROPE_BASE = 10000.0
NSA_WIDTH = NSA_HEADS * NSA_HEAD_DIM
NSA_KV_WIDTH = NSA_KV_GROUPS * NSA_HEAD_DIM
RET_WIDTH = RET_HEADS * RET_HEAD_DIM
MIX_WIDTH = NSA_WIDTH + RET_WIDTH
SPLIT_SIZES = (NSA_WIDTH, 2 * N_BRANCH * NSA_KV_WIDTH, NSA_HEADS * N_BRANCH, 3 * RET_WIDTH, RET_WIDTH)
IN_WIDTH = NSA_WIDTH + 2 * N_BRANCH * NSA_KV_WIDTH + NSA_HEADS * N_BRANCH + 3 * RET_WIDTH + RET_WIDTH
D_FF = 2816
PLE_DIM = 256
N_LN = 4
ALPHA = (2.0 * DEPTH) ** 0.25
BETA = (8.0 * DEPTH) ** -0.25
LN_EPS = 1e-5
NEG = -1e30

kernel_name = "hybrid_nsa_retention_macaron_deepnorm"


def _layer_norm(x, g, b):
    xf = x.astype(jnp.float32)
    mu = jnp.mean(xf, axis=-1, keepdims=True)
    var = jnp.mean(jnp.square(xf - mu), axis=-1, keepdims=True)
    y = (xf - mu) * lax.rsqrt(var + LN_EPS)
    return (y * g.astype(jnp.float32) + b.astype(jnp.float32)).astype(x.dtype)


def _swiglu(x, w13, w2):
    a, u = jnp.split(x @ w13, 2, axis=-1)
    return (jax.nn.silu(a) * u) @ w2


def _rotary(x, pos):
    d = x.shape[-1]
    freqs = ROPE_BASE ** (-jnp.arange(0, d, 2, dtype=jnp.float32) / d)
    ang = pos[:, None] * freqs[None, :]
    cos = jnp.cos(ang)[None, :, None, :]
    sin = jnp.sin(ang)[None, :, None, :]
    x1, x2 = jnp.split(x, 2, axis=-1)
    out = jnp.concatenate([x1 * cos - x2 * sin, x1 * sin + x2 * cos], axis=-1)
    return out.astype(x.dtype)


def _compress(kraw, pos_emb, w1, w2):
    B, G, T, dh = kraw.shape
    n_cmp = (T - CMP_BLOCK) // CMP_STRIDE + 1
    idx = jnp.arange(n_cmp)[:, None] * CMP_STRIDE + jnp.arange(CMP_BLOCK)[None, :]
    blocks = kraw[:, :, idx, :] + pos_emb
    flat = blocks.reshape(B, G, n_cmp, CMP_BLOCK * dh)
    return jax.nn.gelu(flat @ w1) @ w2


def _nsa(q, gates, k_cmp, v_cmp, k_slc, v_slc, k_win, v_win):
    B, G, R, T, dh = q.shape
    n_cmp = k_cmp.shape[2]
    n_slc = T // SLC_BLOCK
    topk = min(SLC_TOPK, n_slc)
    scale = dh ** -0.5
    cmp_start = jnp.arange(n_cmp) * CMP_STRIDE
    cmp_last = cmp_start + CMP_BLOCK - 1
    slc_start = jnp.arange(n_slc) * SLC_BLOCK
    overlap = jnp.clip(jnp.minimum(cmp_start[:, None] + CMP_BLOCK, slc_start[None, :] + SLC_BLOCK)
                       - jnp.maximum(cmp_start[:, None], slc_start[None, :]), 0).astype(jnp.float32) / CMP_BLOCK
    k_blk = k_slc.reshape(B, G, n_slc, SLC_BLOCK, dh)
    v_blk = v_slc.reshape(B, G, n_slc, SLC_BLOCK, dh)
    pad = ((0, 0), (0, 0), (WINDOW, 0), (0, 0))
    k_pad = jnp.pad(k_win, pad)
    v_pad = jnp.pad(v_win, pad)
    bi = jnp.arange(B)[:, None, None, None]
    gi = jnp.arange(G)[None, :, None, None]
    blk_ids = jnp.arange(n_slc)

    def block_fn(qb):
        q0 = qb * Q_BLOCK
        qq = lax.dynamic_slice_in_dim(q, q0, Q_BLOCK, axis=3)
        gg = lax.dynamic_slice_in_dim(gates, q0, Q_BLOCK, axis=3)
        t = q0 + jnp.arange(Q_BLOCK)
        s_c = jnp.einsum('bgrqd,bgcd->bgrqc', qq, k_cmp).astype(jnp.float32) * scale
        mask_c = cmp_last[None, :] <= t[:, None]
        p_c = jax.nn.softmax(jnp.where(mask_c, s_c, NEG), axis=-1) * mask_c
        o_c = jnp.einsum('bgrqc,bgcd->bgrqd', p_c.astype(v_cmp.dtype), v_cmp)
        imp = jnp.einsum('bgrqc,cs->bgqs', p_c, overlap)
        cur = t // SLC_BLOCK
        forced = (blk_ids[None, :] == 0) | (blk_ids[None, :] == cur[:, None]) | (blk_ids[None, :] == cur[:, None] - 1)
        valid_b = slc_start[None, :] <= t[:, None]
        imp = jnp.where(valid_b, jnp.where(forced, jnp.inf, imp), -jnp.inf)
        _, sel = lax.top_k(imp, topk)
        key_pos = sel[..., None] * SLC_BLOCK + jnp.arange(SLC_BLOCK)
        mask_s = (key_pos <= t[None, None, :, None, None]).reshape(B, G, Q_BLOCK, topk * SLC_BLOCK)
        ks = k_blk[bi, gi, sel].reshape(B, G, Q_BLOCK, topk * SLC_BLOCK, dh)
        vs = v_blk[bi, gi, sel].reshape(B, G, Q_BLOCK, topk * SLC_BLOCK, dh)
        s_s = jnp.einsum('bgrqd,bgqkd->bgrqk', qq, ks).astype(jnp.float32) * scale
        p_s = jax.nn.softmax(jnp.where(mask_s[:, :, None], s_s, NEG), axis=-1)
        o_s = jnp.einsum('bgrqk,bgqkd->bgrqd', p_s.astype(vs.dtype), vs)
        kw = lax.dynamic_slice_in_dim(k_pad, q0, WINDOW + Q_BLOCK, axis=2)
        vw = lax.dynamic_slice_in_dim(v_pad, q0, WINDOW + Q_BLOCK, axis=2)
        kpos = q0 - WINDOW + jnp.arange(WINDOW + Q_BLOCK)
        dist = t[:, None] - kpos[None, :]
        mask_w = (kpos[None, :] >= 0) & (dist >= 0) & (dist < WINDOW)
        s_w = jnp.einsum('bgrqd,bgkd->bgrqk', qq, kw).astype(jnp.float32) * scale
        p_w = jax.nn.softmax(jnp.where(mask_w, s_w, NEG), axis=-1)
        o_w = jnp.einsum('bgrqk,bgkd->bgrqd', p_w.astype(vw.dtype), vw)
        out = gg[..., 0:1] * o_c + gg[..., 1:2] * o_s + gg[..., 2:3] * o_w
        return out.astype(q.dtype)

    outs = lax.map(block_fn, jnp.arange(T // Q_BLOCK))
    return outs.transpose(1, 0, 4, 2, 3, 5).reshape(B, T, G * R * dh)


def _retention(q, k, v, gn_g, gn_b):
    B, T, H, d = q.shape
    C = RET_CHUNK
    N = T // C
    gamma = 1.0 - jnp.exp2(-5.0 - jnp.arange(H, dtype=jnp.float32))
    log_g = jnp.log(gamma)
    pos = jnp.arange(T, dtype=jnp.float32)
    q = _rotary(q, pos)
    k = _rotary(k, pos) * (d ** -0.5)
    to_chunks = lambda a: a.reshape(B, N, C, H, d).transpose(0, 3, 1, 2, 4)
    qc, kc, vc = to_chunks(q), to_chunks(k), to_chunks(v)
    i = jnp.arange(C, dtype=jnp.float32)
    rel = i[:, None] - i[None, :]
    decay = jnp.where(rel[None] >= 0, jnp.exp(jnp.maximum(rel, 0.0)[None] * log_g[:, None, None]), 0.0)
    inner = jnp.einsum('bhnid,bhnjd->bhnij', qc, kc) * decay[:, None]
    o_inner = jnp.einsum('bhnij,bhnjd->bhnid', inner, vc)
    zeta = jnp.exp((C - 1.0 - i)[None, :] * log_g[:, None])
    xi = jnp.exp((i + 1.0)[None, :] * log_g[:, None])
    kv = jnp.einsum('bhnjd,bhnje->nbhde', kc * zeta[:, None, :, None], vc)
    g_chunk = jnp.exp(C * log_g)[None, :, None, None]

    def step(state, kv_n):
        return g_chunk * state + kv_n, state

    _, s_prev = lax.scan(step, jnp.zeros((B, H, d, d), kv.dtype), kv)
    o_cross = jnp.einsum('bhnid,nbhde->bhnie', qc * xi[:, None, :, None], s_prev)
    o = (o_inner + o_cross).astype(jnp.float32).transpose(0, 2, 3, 1, 4).reshape(B, T, H, d)
    mu = jnp.mean(o, axis=-1, keepdims=True)
    var = jnp.mean(jnp.square(o - mu), axis=-1, keepdims=True)
    o = ((o - mu) * lax.rsqrt(var + LN_EPS)).reshape(B, T, H * d)
    return (o * gn_g.astype(jnp.float32) + gn_b.astype(jnp.float32)).astype(v.dtype)


def _token_mixer(h, w_in, cmp_pos, cmp_w1, cmp_w2, gn_g, gn_b, w_out):
    B, T, _ = h.shape
    proj = h @ w_in
    cuts = np.cumsum(SPLIT_SIZES)[:-1].tolist()
    q_n, kv_n, g_n, qkv_r, g_r = jnp.split(proj, cuts, axis=-1)
    q_nsa = q_n.reshape(B, T, NSA_KV_GROUPS, NSA_REP, NSA_HEAD_DIM).transpose(0, 2, 3, 1, 4)
    kvs = kv_n.reshape(B, T, 2 * N_BRANCH, NSA_KV_GROUPS, NSA_HEAD_DIM).transpose(2, 0, 3, 1, 4)
    k_cmp = _compress(kvs[0], cmp_pos[0], cmp_w1[0], cmp_w2[0])
    v_cmp = _compress(kvs[1], cmp_pos[1], cmp_w1[1], cmp_w2[1])
    gates = jax.nn.sigmoid(g_n.astype(jnp.float32)).reshape(B, T, NSA_KV_GROUPS, NSA_REP, N_BRANCH).transpose(0, 2, 3, 1, 4)
    o_nsa = _nsa(q_nsa, gates, k_cmp, v_cmp, kvs[2], kvs[3], kvs[4], kvs[5])
    q_r, k_r, v_r = [a.reshape(B, T, RET_HEADS, RET_HEAD_DIM) for a in jnp.split(qkv_r, 3, axis=-1)]
    o_ret = jax.nn.silu(g_r) * _retention(q_r, k_r, v_r, gn_g, gn_b)
    return jnp.concatenate([o_nsa, o_ret.astype(o_nsa.dtype)], axis=-1) @ w_out


def setup_inputs(seed: int = 0) -> dict:
    key = jax.random.key(seed)
    ks = jax.random.split(key, 16)
    f32 = jnp.float32
    nrm = lambda k, shape, s: jax.random.normal(k, shape, f32) * s
    return {
        "x": nrm(ks[0], (BATCH, SEQ, D_MODEL), 1.0),
        "p": nrm(ks[1], (DEPTH, BATCH, SEQ, PLE_DIM), 1.0),
        "ffn_w13": nrm(ks[2], (DEPTH, 2, D_MODEL, 2 * D_FF), D_MODEL ** -0.5),
        "ffn_w2": nrm(ks[3], (DEPTH, 2, D_FF, D_MODEL), BETA * D_FF ** -0.5),
        "w_in": nrm(ks[4], (DEPTH, D_MODEL, IN_WIDTH), D_MODEL ** -0.5),
        "cmp_pos": nrm(ks[5], (DEPTH, 2, CMP_BLOCK, NSA_HEAD_DIM), 0.1),
        "cmp_w1": nrm(ks[6], (DEPTH, 2, CMP_BLOCK * NSA_HEAD_DIM, CMP_HIDDEN), (CMP_BLOCK * NSA_HEAD_DIM) ** -0.5),
        "cmp_w2": nrm(ks[7], (DEPTH, 2, CMP_HIDDEN, NSA_HEAD_DIM), CMP_HIDDEN ** -0.5),
        "ret_gn_g": 1.0 + nrm(ks[8], (DEPTH, RET_WIDTH), 0.02),
        "ret_gn_b": nrm(ks[9], (DEPTH, RET_WIDTH), 0.02),
        "w_out": nrm(ks[10], (DEPTH, MIX_WIDTH, D_MODEL), BETA * MIX_WIDTH ** -0.5),
        "w_ple": nrm(ks[11], (DEPTH, PLE_DIM, D_MODEL), BETA * PLE_DIM ** -0.5),
        "w_ple_gate": nrm(ks[12], (DEPTH, D_MODEL, D_MODEL), D_MODEL ** -0.5),
        "ln_g": 1.0 + nrm(ks[13], (DEPTH, N_LN, D_MODEL), 0.02),
        "ln_b": nrm(ks[14], (DEPTH, N_LN, D_MODEL), 0.02),
    }


def reference(x, p, ffn_w13, ffn_w2, w_in, cmp_pos, cmp_w1, cmp_w2, ret_gn_g, ret_gn_b,
              w_out, w_ple, w_ple_gate, ln_g, ln_b):
    for i in range(DEPTH):
        x = _layer_norm(ALPHA * x + 0.5 * _swiglu(x, ffn_w13[i, 0], ffn_w2[i, 0]), ln_g[i, 0], ln_b[i, 0])
        mix = _token_mixer(x, w_in[i], cmp_pos[i], cmp_w1[i], cmp_w2[i], ret_gn_g[i], ret_gn_b[i], w_out[i])
        x = _layer_norm(ALPHA * x + mix, ln_g[i, 1], ln_b[i, 1])
        x = _layer_norm(ALPHA * x + 0.5 * _swiglu(x, ffn_w13[i, 1], ffn_w2[i, 1]), ln_g[i, 2], ln_b[i, 2])
        e = (p[i] @ w_ple[i]) * jax.nn.sigmoid(x @ w_ple_gate[i])
        x = _layer_norm(ALPHA * x + e, ln_g[i, 3], ln_b[i, 3])
    return x
```

```cpp
#include <hip/hip_runtime.h>
#include <cstdio>
#include <cstdint>
namespace pg8 {
#define PG8_LAS __attribute__((address_space(3)))
typedef unsigned short bf16_t;
typedef short bf16x8 __attribute__((ext_vector_type(8)));
typedef float f32x4 __attribute__((ext_vector_type(4)));
typedef unsigned u32x4 __attribute__((ext_vector_type(4)));
constexpr int BM = 256, BK = 64, HALF = 128, HTB = HALF * BK * 2  , STAGE_BYTES = 8 * HTB, NXCD = 8, WGM = 8;

__host__ __device__ __forceinline__ int lds_byte(int r, int c) { const int st = (r >> 4) * 2 + (c >> 5), rr = r & 15, cc = c & 31, ob = rr * 64 + cc * 2; return st * 1024 + (ob ^ (((ob >> 9) & 1) << 5)); }
__host__ __device__ __forceinline__ void stage_rc(int b, int& R, int& C) { const int st = b / 1024, sb = b % 1024, swz = sb ^ (((sb >> 9) & 1) << 5); R = (st >> 1) * 16 + swz / 64; C = (st & 1) * 32 + (swz % 64) / 2; }
__host__ __device__ __forceinline__ int perm32(int rho) { const int n = rho >> 4, i = rho & 15; return 8 * (i >> 2) + 4 * n + (i & 3); }

struct Unit { int pm, pn; };
struct Gemm { const bf16_t* A; const bf16_t* Bt; int M, N, K, lda; };

struct StaticOrder {
    int nM, nN, nwg, G, c;
    __host__ __device__ void init(int M, int N, int G_, int c_) { nM = M / BM; nN = N / BM; nwg = nM * nN; G = G_; c = c_; }
    __host__ __device__ bool next(int i, Unit& u) const {
        const long L = (long)i * G + c; if (L >= nwg) return false;
        int wgid = (int)L; { const int q = nwg / NXCD, r = nwg % NXCD, xcd = wgid % NXCD, off = wgid / NXCD; wgid = (xcd < r ? xcd * (q + 1) : r * (q + 1) + (xcd - r) * q) + off; }
        const int nig = WGM * nN, gid = wgid / nig, fm = gid * WGM, gsz = (nM - fm) < WGM ? (nM - fm) : WGM;
        u.pm = fm + ((wgid % nig) % gsz); u.pn = (wgid % nig) / gsz; return true;
    }
    __device__ __forceinline__ void a_ready(const Unit&) const {}
    __device__ __forceinline__ void done(const Unit&) const {}
};

typedef float f32x2_cv __attribute__((ext_vector_type(2))); typedef __bf16 bf16x2_cv __attribute__((ext_vector_type(2)));
__device__ __forceinline__ unsigned cvt_pk_bf16(float lo, float hi) { f32x2_cv v = {lo, hi}; bf16x2_cv b = __builtin_convertvector(v, bf16x2_cv); return __builtin_bit_cast(unsigned, b); }
template <class Epi, class Sched, bool ALIGN_EPI = false, bool SP2 = false>
__device__ __forceinline__ void gemm_phase(PG8_LAS unsigned char* lds, const Gemm g, const Sched& S, const Epi& E) {
    int tid_ = threadIdx.x; asm volatile("" : "+v"(tid_));
    const int tid = tid_, wid = __builtin_amdgcn_readfirstlane(tid >> 6), lane = tid & 63, wr = wid >> 2, wc = wid & 3, fr = lane & 15, fq = lane >> 4;
    const int K = g.K, nt = K / BK;
    unsigned voffA[2], voffB[2];
#pragma unroll
    for (int i = 0; i < 2; ++i) { int R, C; stage_rc(tid * 16 + i * 8192, R, C); const int Rb = Epi::PERM ? ((R & ~31) + perm32(R & 31)) : R;
        voffA[i] = (unsigned)(R * g.lda + C) * 2u; voffB[i] = (unsigned)(Rb * K + C) * 2u; }
    const size_t kstep = (size_t)(BK * 2);
    const size_t hstepA = (size_t)HALF * g.lda * 2, hstepB = (size_t)HALF * K * 2;
    const size_t tstepA = 2 * hstepA, tstepB = 2 * hstepB;
    const unsigned ldsw = (unsigned)wid * 1024u;
    const int aoff = lds_byte(wr * 64 + fr, fq * 8), boff = lds_byte(wc * 32 + fr, fq * 8);
#define PG8_SA(b, h) (((b) * 2 + (h)) * HTB)
#define PG8_SB(b, h) ((4 + (b) * 2 + (h)) * HTB)
#define PG8_STAGE(bufoff, gbase, voff) do { _Pragma("unroll") for (int _i = 0; _i < 2; ++_i) \
        __builtin_amdgcn_global_load_lds((const unsigned*)((const char*)(gbase) + (voff)[_i]), (PG8_LAS unsigned*)(lds + (bufoff) + ldsw + _i * 8192), 16, 0, 0); } while (0)
#define PG8_LDA(dst, b, h) do { _Pragma("unroll") for (int m = 0; m < 4; ++m) _Pragma("unroll") for (int k = 0; k < 2; ++k) dst[m][k] = *(const PG8_LAS bf16x8*)(lds + PG8_SA(b, h) + aoff + m * 2048 + k * 1024); } while (0)
#define PG8_LDB(dst, b, h) do { _Pragma("unroll") for (int n = 0; n < 2; ++n) _Pragma("unroll") for (int k = 0; k < 2; ++k) dst[n][k] = *(const PG8_LAS bf16x8*)(lds + PG8_SB(b, h) + boff + n * 2048 + k * 1024); } while (0)
#define PG8_MMA(ai, bj, At, Bt) do { __builtin_amdgcn_s_setprio(1); _Pragma("unroll") for (int m = 0; m < 4; ++m) _Pragma("unroll") for (int n = 0; n < 2; ++n) _Pragma("unroll") for (int k = 0; k < 2; ++k) \
        acc[ai][bj][m][n] = __builtin_amdgcn_mfma_f32_16x16x32_bf16(Bt[n][k], At[m][k], acc[ai][bj][m][n], 0, 0, 0); __builtin_amdgcn_s_setprio(0); } while (0)
#define PG8_WAIT_V(n) asm volatile("s_waitcnt vmcnt(" #n ")" ::: "memory")
#define PG8_WAIT_L(n) asm volatile("s_waitcnt lgkmcnt(" #n ")" ::: "memory")
#define PG8_BAR __builtin_amdgcn_s_barrier()
#define PG8_SCHED __builtin_amdgcn_sched_barrier(0)
    Unit cur, nxt; int ui = 0;
    if (!S.next(0, cur)) return;
    f32x4 acc[2][2][4][2];
#pragma unroll
    for (int a = 0; a < 2; ++a)
#pragma unroll
        for (int b = 0; b < 2; ++b)
#pragma unroll
            for (int m = 0; m < 4; ++m)
#pragma unroll
                for (int n = 0; n < 2; ++n) acc[a][b][m][n] = (f32x4){0.f, 0.f, 0.f, 0.f};
    bf16x8 At[4][2], B0[2][2], B1[2][2];
    const char* cA = (const char*)g.A + (size_t)cur.pm * tstepA; const char* cB = (const char*)g.Bt + (size_t)cur.pn * tstepB;
    S.a_ready(cur);
    if constexpr (SP2) {
        PG8_STAGE(PG8_SB(0, 0), cB, voffB); PG8_STAGE(PG8_SB(0, 1), cB + hstepB, voffB); PG8_STAGE(PG8_SA(0, 0), cA, voffA); PG8_STAGE(PG8_SA(0, 1), cA + hstepA, voffA);
        if (wr == 1) PG8_BAR;
        PG8_WAIT_V(2); PG8_BAR;
        PG8_STAGE(PG8_SB(1, 0), cB + kstep, voffB); PG8_STAGE(PG8_SA(1, 0), cA + kstep, voffA); PG8_STAGE(PG8_SB(1, 1), cB + hstepB + kstep, voffB);
        PG8_WAIT_V(6); PG8_BAR;
    } else {
        PG8_STAGE(PG8_SB(0, 0), cB, voffB); PG8_STAGE(PG8_SA(0, 0), cA, voffA); PG8_STAGE(PG8_SB(0, 1), cB + hstepB, voffB); PG8_STAGE(PG8_SA(0, 1), cA + hstepA, voffA);
        if (wr == 1) PG8_BAR;
        PG8_WAIT_V(4); PG8_BAR;
        PG8_STAGE(PG8_SB(1, 0), cB + kstep, voffB); PG8_STAGE(PG8_SA(1, 0), cA + kstep, voffA); PG8_STAGE(PG8_SB(1, 1), cB + hstepB + kstep, voffB);
        PG8_WAIT_V(6); PG8_BAR;
    }
    for (;;) {
        const bool has_next = S.next(ui + 1, nxt);
        const char* nA = has_next ? (const char*)g.A + (size_t)nxt.pm * tstepA : cA; const char* nB = has_next ? (const char*)g.Bt + (size_t)nxt.pn * tstepB : cB;
        for (int t = 0; t < nt; t += 2) {
            const bool last = (t == nt - 2);
            const char* a1 = cA + (size_t)(t + 1) * kstep;
            const char* a2 = last ? nA : cA + (size_t)(t + 2) * kstep; const char* b2 = last ? nB : cB + (size_t)(t + 2) * kstep;
            const char* a3 = a2 + kstep; const char* b3 = b2 + kstep;
            if (last && has_next) S.a_ready(nxt);
            if constexpr (SP2) {
            PG8_LDB(B0, 0, 0); PG8_LDB(B1, 0, 1); PG8_SCHED; PG8_LDA(At, 0, 0); PG8_STAGE(PG8_SA(1, 1), a1 + hstepA, voffA);
            PG8_WAIT_V(8); PG8_WAIT_L(0); PG8_BAR; PG8_MMA(0, 0, At, B0); PG8_MMA(0, 1, At, B1); PG8_BAR; PG8_SCHED;
            PG8_LDA(At, 0, 1); PG8_STAGE(PG8_SB(0, 0), b2, voffB); PG8_STAGE(PG8_SB(0, 1), b2 + hstepB, voffB); PG8_STAGE(PG8_SA(0, 0), a2, voffA);
            PG8_WAIT_V(8); PG8_WAIT_L(0); PG8_BAR; PG8_MMA(1, 0, At, B0); PG8_MMA(1, 1, At, B1); PG8_BAR; PG8_SCHED;
            PG8_LDB(B0, 1, 0); PG8_LDB(B1, 1, 1); PG8_SCHED; PG8_LDA(At, 1, 0); PG8_STAGE(PG8_SA(0, 1), a2 + hstepA, voffA);
            PG8_WAIT_V(8); PG8_WAIT_L(0); PG8_BAR; PG8_MMA(0, 0, At, B0); PG8_MMA(0, 1, At, B1); PG8_BAR; PG8_SCHED;
            PG8_LDA(At, 1, 1); PG8_STAGE(PG8_SB(1, 0), b3, voffB); PG8_STAGE(PG8_SB(1, 1), b3 + hstepB, voffB); PG8_STAGE(PG8_SA(1, 0), a3, voffA);
            PG8_WAIT_V(8); PG8_WAIT_L(0); PG8_BAR; PG8_MMA(1, 0, At, B0); PG8_MMA(1, 1, At, B1); PG8_BAR; PG8_SCHED;
            } else {
            PG8_LDB(B0, 0, 0); PG8_SCHED; PG8_LDA(At, 0, 0); PG8_STAGE(PG8_SA(1, 1), a1 + hstepA, voffA);
            PG8_WAIT_L(8); PG8_BAR; PG8_WAIT_L(0); PG8_MMA(0, 0, At, B0); PG8_BAR; PG8_SCHED;
            PG8_LDB(B1, 0, 1); PG8_STAGE(PG8_SB(0, 0), b2, voffB);
            PG8_BAR; PG8_WAIT_L(0); PG8_MMA(0, 1, At, B1); PG8_BAR;
            PG8_LDA(At, 0, 1); PG8_STAGE(PG8_SA(0, 0), a2, voffA);
            PG8_BAR; PG8_WAIT_L(0); PG8_MMA(1, 0, At, B0); PG8_BAR; PG8_SCHED;
            PG8_STAGE(PG8_SB(0, 1), b2 + hstepB, voffB);
            PG8_WAIT_V(6); PG8_BAR; PG8_MMA(1, 1, At, B1); PG8_BAR;
            PG8_LDB(B0, 1, 0); PG8_SCHED; PG8_LDA(At, 1, 0); PG8_STAGE(PG8_SA(0, 1), a2 + hstepA, voffA);
            PG8_WAIT_L(8); PG8_BAR; PG8_WAIT_L(0); PG8_MMA(0, 0, At, B0); PG8_BAR; PG8_SCHED;
            PG8_LDB(B1, 1, 1); PG8_STAGE(PG8_SB(1, 0), b3, voffB);
            PG8_BAR; PG8_WAIT_L(0); PG8_MMA(0, 1, At, B1); PG8_BAR;
            PG8_LDA(At, 1, 1); PG8_STAGE(PG8_SA(1, 0), a3, voffA);
            PG8_BAR; PG8_WAIT_L(0); PG8_MMA(1, 0, At, B0); PG8_BAR; PG8_SCHED;
            PG8_STAGE(PG8_SB(1, 1), b3 + hstepB, voffB);
            PG8_WAIT_V(6); PG8_BAR; PG8_MMA(1, 1, At, B1); PG8_BAR;
            }
        }
        if constexpr (ALIGN_EPI) { if (wr == 0) PG8_BAR; }
        if constexpr (!Epi::AFTER_DRAIN) { E(acc, cur, wr, wc, fr, fq); S.done(cur); }
        if (!has_next) break;
#pragma unroll
        for (int a = 0; a < 2; ++a)
#pragma unroll
            for (int b = 0; b < 2; ++b)
#pragma unroll
                for (int m = 0; m < 4; ++m)
#pragma unroll
                    for (int n = 0; n < 2; ++n) acc[a][b][m][n] = (f32x4){0.f, 0.f, 0.f, 0.f};
        cur = nxt; cA = nA; cB = nB; ++ui;
        if constexpr (ALIGN_EPI) { if (wr == 1) PG8_BAR; }
    }
    PG8_WAIT_V(0);
    if constexpr (!ALIGN_EPI) { if (wr == 0) PG8_BAR; }
    PG8_BAR;
    if constexpr (Epi::AFTER_DRAIN) { E.fused(acc, cur, wr, wc, fr, fq, lds, wid, lane); S.done(cur); }
#undef PG8_SA
#undef PG8_SB
#undef PG8_STAGE
#undef PG8_LDA
#undef PG8_LDB
#undef PG8_MMA
#undef PG8_WAIT_V
#undef PG8_WAIT_L
#undef PG8_BAR
#undef PG8_SCHED
}
}

using pg8::bf16_t; using pg8::f32x4; using pg8::u32x4; using pg8::Unit;
typedef unsigned u32x2 __attribute__((ext_vector_type(2)));
constexpr int NTHREADS = 512;
constexpr int LDS_BYTES = 147456;
constexpr int SEQ = 8192, DM = 1024, M = 4 * SEQ;
constexpr int DFF = 2816, NIN = 3352, NINP = 3584, PLE = 256;
constexpr int HP = 2944;
constexpr float ALPHA = 1.189207115002721f;
constexpr float LN_EPS = 1e-5f;
constexpr size_t MiB = 1u << 20;
constexpr size_t OFF_VEC = 1 * MiB;
constexpr size_t OFF_ROT = 4 * MiB;
constexpr size_t OFF_STATS = 8 * MiB;
constexpr size_t OFF_W = 24 * MiB;
constexpr size_t OFF_YB = 72 * MiB;
constexpr size_t OFF_PB = 136 * MiB;
constexpr size_t OFF_PE = 152 * MiB;
constexpr size_t OFF_HB = 216 * MiB;
constexpr size_t OFF_SG = 400 * MiB;
constexpr size_t OFF_GATES = 432 * MiB;
constexpr size_t OFF_KVST = 436 * MiB;
constexpr size_t OFF_CH = 500 * MiB;
constexpr size_t OFF_KCMP = 504 * MiB;
constexpr size_t WS_NEED = 505 * MiB;
constexpr size_t W_13A = 0, W_13B = W_13A + (size_t)5632 * 1024, W_2A = W_13B + (size_t)5632 * 1024, W_2B = W_2A + (size_t)1024 * 2816,
                 W_IN = W_2B + (size_t)1024 * 2816, W_C1K = W_IN + (size_t)NINP * 1024, W_C1V = W_C1K + 256 * 2048, W_C2K = W_C1V + 256 * 2048,
                 W_C2V = W_C2K + 256 * 256, W_OUT = W_C2V + 256 * 256, W_PLE = W_OUT + 1024 * 1024, W_PG = W_PLE + 1024 * 256, W_END = W_PG + 1024 * 1024;
static_assert(W_END * 2 <= 48 * MiB, "weights region");
constexpr int NCV = NINP + 5632 + 1024;
constexpr int V_C1 = 0, V_C2 = V_C1 + NCV, V_CB = V_C2 + NCV, V_CPART = V_CB + 512, V_CBP = V_CPART + 16 * NCV * 2, V_END = V_CBP + 32 * 512;
static_assert((size_t)V_END * 4 <= 3 * MiB, "vec region");
constexpr size_t HB_QN = 0, HB_KV = HB_QN + (size_t)M * 512, KVSZ = (size_t)8 * SEQ * 64, HB_QR = HB_KV + 6 * KVSZ, HB_KR = HB_QR + (size_t)M * 512, HB_VR = HB_KR + (size_t)M * 512;
static_assert((HB_VR + (size_t)M * 512) * 2 <= 176 * MiB, "HB overlay");
constexpr size_t KCMP_J = (size_t)4096 * 64;

struct Args { const float* in[15]; float* out; unsigned char* ws; };

__device__ __forceinline__ float bf2f(unsigned h) { return __uint_as_float(h << 16); }
__device__ __forceinline__ float bflo(unsigned w) { return __uint_as_float(w << 16); }
__device__ __forceinline__ float bfhi(unsigned w) { return __uint_as_float(w & 0xffff0000u); }
__device__ __forceinline__ unsigned f2bf(float f) { unsigned u = __float_as_uint(f); return (u + 0x7fffu + ((u >> 16) & 1u)) >> 16; }
__device__ __forceinline__ float bfround(float f) { return __uint_as_float(f2bf(f) << 16); }
__device__ __forceinline__ u32x4 pack8(f32x4 a, f32x4 b) { u32x4 w; w.x = pg8::cvt_pk_bf16(a[0], a[1]); w.y = pg8::cvt_pk_bf16(a[2], a[3]); w.z = pg8::cvt_pk_bf16(b[0], b[1]); w.w = pg8::cvt_pk_bf16(b[2], b[3]); return w; }
__device__ __forceinline__ float sigmoid_f(float v) { return __builtin_amdgcn_rcpf(1.f + __builtin_amdgcn_exp2f(-1.4426950408889634f * v)); }
__device__ __forceinline__ float silu_f(float v) { return v * __builtin_amdgcn_rcpf(1.f + __builtin_amdgcn_exp2f(-1.4426950408889634f * v)); }
__device__ __forceinline__ float gelu_tanh_f(float v) { const float u = 0.7978845608028654f * (v + 0.044715f * v * v * v); return v * __builtin_amdgcn_rcpf(1.f + __builtin_amdgcn_exp2f(-2.8853900817779268f * u)); }
__device__ __forceinline__ f32x4 silu4(f32x4 v) { return (f32x4){silu_f(v[0]), silu_f(v[1]), silu_f(v[2]), silu_f(v[3])}; }
__device__ __forceinline__ f32x4 sigmoid4(f32x4 v) { return (f32x4){sigmoid_f(v[0]), sigmoid_f(v[1]), sigmoid_f(v[2]), sigmoid_f(v[3])}; }
__device__ __forceinline__ float hsum4(f32x4 v) { return (v[0] + v[1]) + (v[2] + v[3]); }
__device__ __forceinline__ float xsum16(float a) { auto rr = __builtin_amdgcn_permlane16_swap(__float_as_uint(a), __float_as_uint(a), false, false); return __uint_as_float(rr[0]) + __uint_as_float(rr[1]); }
__device__ __forceinline__ float xsum32(float a) { auto rr = __builtin_amdgcn_permlane32_swap(__float_as_uint(a), __float_as_uint(a), false, false); return __uint_as_float(rr[0]) + __uint_as_float(rr[1]); }
__device__ __forceinline__ float wave_max(float v) {
#pragma unroll
    for (int o = 1; o < 64; o <<= 1) v = fmaxf(v, __shfl_xor(v, o));
    return v; }
__device__ __forceinline__ float wave_sum(float v) {
#pragma unroll
    for (int o = 1; o < 64; o <<= 1) v += __shfl_xor(v, o);
    return v; }
__device__ __forceinline__ int wave_min_i(int v) {
#pragma unroll
    for (int o = 1; o < 64; o <<= 1) { const int w = __shfl_xor(v, o); v = w < v ? w : v; }
    return v; }
__device__ __forceinline__ void row_stats(const float* st, int row, float& mu, float& rs) {
    const f32x4* p = (const f32x4*)(st + (size_t)row * 32);
    float s = 0.f, q = 0.f;
#pragma unroll
    for (int i = 0; i < 8; ++i) { const f32x4 v = p[i]; s += v[0] + v[2]; q += v[1] + v[3]; }
    mu = s * (1.f / 1024.f); const float var = fmaxf(q * (1.f / 1024.f) - mu * mu, 0.f); rs = rsqrtf(var + LN_EPS);
}

__device__ __forceinline__ void panel_stats(const float* st, int pm, float2* tab) {
    int t_ = threadIdx.x; asm volatile("" : "+v"(t_)); const int t = t_, row = t >> 1, half = t & 1;
    const f32x4* p = (const f32x4*)(st + (size_t)(pm * 256 + row) * 32 + half * 16);
    float s = 0.f, q = 0.f;
#pragma unroll
    for (int i = 0; i < 4; ++i) { const f32x4 v = p[i]; s += v[0] + v[2]; q += v[1] + v[3]; }
    s += __shfl_xor(s, 1); q += __shfl_xor(q, 1);
    const float mu = s * (1.f / 1024.f), var = fmaxf(q * (1.f / 1024.f) - mu * mu, 0.f);
    if (half == 0) tab[row] = make_float2(mu, rsqrtf(var + LN_EPS));
    asm volatile("s_waitcnt lgkmcnt(0)" ::: "memory"); __builtin_amdgcn_s_barrier(); asm volatile("" ::: "memory");
}

template <bool LN> struct EpiRes {
    static constexpr bool PERM = true, AFTER_DRAIN = false;
    const bf16_t* xb; bf16_t* yb; float* st_out; const float* st_in; const float* lg; const float* lb; float coef; float2* tab;
    __device__ __forceinline__ void operator()(const f32x4 (&acc)[2][2][4][2], const Unit& u, int wr, int wc, int fr, int fq) const {
        const int colw = wc * 32 + 8 * fq;
        constexpr int NB = LN ? 2 : 1, RB = 8 / NB;
        f32x4 gv[2][2], bv[2][2];
#pragma unroll
        for (int bj = 0; bj < 2; ++bj)
#pragma unroll
            for (int n = 0; n < 2; ++n) { const int col = u.pn * 256 + bj * 128 + colw + 4 * n;
                gv[bj][n] = LN ? *(const f32x4*)(lg + col) : (f32x4){1.f, 1.f, 1.f, 1.f}; bv[bj][n] = LN ? *(const f32x4*)(lb + col) : (f32x4){0.f, 0.f, 0.f, 0.f}; }
        u32x4 xw[RB][2];
#define ER_LOAD(bt) do { _Pragma("unroll") for (int k = 0; k < RB; ++k) { const int rr_ = (bt) * RB + k, ai_ = rr_ >> 2, m_ = rr_ & 3; \
            _Pragma("unroll") for (int bj = 0; bj < 2; ++bj) xw[k][bj] = *(const u32x4*)(xb + (size_t)(u.pm * 256 + ai_ * 128 + wr * 64 + m_ * 16 + fr) * DM + u.pn * 256 + bj * 128 + colw); } } while (0)
        ER_LOAD(0);
        if (LN) panel_stats(st_in, u.pm, tab);
#pragma unroll
        for (int bt = 0; bt < NB; ++bt) {
            if (bt > 0) ER_LOAD(bt);
            __builtin_amdgcn_sched_barrier(0);
#pragma unroll
            for (int k = 0; k < RB; ++k) { const int rr = bt * RB + k, ai = rr >> 2, m = rr & 3;
                const int row = u.pm * 256 + ai * 128 + wr * 64 + m * 16 + fr;
                float mu = 0.f, rs = 1.f; if (LN) { const float2 mr = tab[ai * 128 + wr * 64 + m * 16 + fr]; mu = mr.x; rs = mr.y; }
                float s = 0.f, q = 0.f;
#pragma unroll
                for (int bj = 0; bj < 2; ++bj) {
                    const u32x4 w = xw[k][bj];
                    f32x4 x0 = (f32x4){bflo(w.x), bfhi(w.x), bflo(w.y), bfhi(w.y)}, x1 = (f32x4){bflo(w.z), bfhi(w.z), bflo(w.w), bfhi(w.w)};
                    if (LN) { x0 = (x0 - mu) * rs * gv[bj][0] + bv[bj][0]; x1 = (x1 - mu) * rs * gv[bj][1] + bv[bj][1]; }
                    const size_t off = (size_t)row * DM + u.pn * 256 + bj * 128 + colw;
                    const f32x4 y0 = x0 * ALPHA + acc[ai][bj][m][0] * coef, y1 = x1 * ALPHA + acc[ai][bj][m][1] * coef;
                    const u32x4 yw = pack8(y0, y1);
                    *(u32x4*)(yb + off) = yw;
                    s += hsum4(y0) + hsum4(y1); q += hsum4(y0 * y0) + hsum4(y1 * y1);
                }
                s = xsum32(xsum16(s)); q = xsum32(xsum16(q));
                if (fq == 0) *(float2*)(st_out + (size_t)row * 32 + (u.pn * 4 + wc) * 2) = make_float2(s, q);
            }
        }
#undef ER_LOAD
    }
};

template <bool FOLD> struct EpiSwigluT {
    static constexpr bool PERM = true, AFTER_DRAIN = false;
    bf16_t* O; const float* st_in; const float* c1; const float* c2; float2* tab;
    mutable int last_pm = -1;
    __device__ __forceinline__ void operator()(const f32x4 (&acc)[2][2][4][2], const Unit& u, int wr, int wc, int fr, int fq) const {
        const int colw = wc * 32 + 8 * fq, nb = u.pn * 256 + colw;
        if (FOLD && u.pm != last_pm) { panel_stats(st_in, u.pm, tab); last_pm = u.pm; }
        f32x4 k1[2][2], k2[2][2];
#pragma unroll
        for (int bj = 0; bj < 2; ++bj)
#pragma unroll
            for (int n = 0; n < 2; ++n) { k1[bj][n] = FOLD ? *(const f32x4*)(c1 + nb + bj * 128 + 4 * n) : (f32x4){0.f, 0.f, 0.f, 0.f}; k2[bj][n] = FOLD ? *(const f32x4*)(c2 + nb + bj * 128 + 4 * n) : (f32x4){0.f, 0.f, 0.f, 0.f}; }
#pragma unroll
        for (int ai = 0; ai < 2; ++ai)
#pragma unroll
            for (int m = 0; m < 4; ++m) {
                const int row = u.pm * 256 + ai * 128 + wr * 64 + m * 16 + fr;
                float mu = 0.f, rs = 1.f; if (FOLD) { const float2 mr = tab[ai * 128 + wr * 64 + m * 16 + fr]; mu = mr.x; rs = mr.y; }
                f32x4 h[2];
#pragma unroll
                for (int n = 0; n < 2; ++n) {
                    const f32x4 a = FOLD ? (acc[ai][0][m][n] - k1[0][n] * mu) * rs + k2[0][n] : acc[ai][0][m][n], g = FOLD ? (acc[ai][1][m][n] - k1[1][n] * mu) * rs + k2[1][n] : acc[ai][1][m][n];
                    h[n] = silu4(a) * g; }
                *(u32x4*)(O + (size_t)row * HP + u.pn * 128 + colw) = pack8(h[0], h[1]);
            }
    }
};

struct EpiInProj {
    static constexpr bool PERM = true, AFTER_DRAIN = false;
    const float* st_in; const float* c1; const float* c2;
    bf16_t* qn; bf16_t* kv; bf16_t* qr; bf16_t* kr; bf16_t* vr; bf16_t* sg; float* gates; float2* tab;
    mutable int last_pm = -1;
    __device__ __forceinline__ void operator()(const f32x4 (&acc)[2][2][4][2], const Unit& u, int wr, int wc, int fr, int fq) const {
        const int pn = u.pn, colw = wc * 32 + 8 * fq, nb = pn * 256 + colw;
        if (u.pm != last_pm) { panel_stats(st_in, u.pm, tab); last_pm = u.pm; }
        f32x4 k1[2][2], k2[2][2];
#pragma unroll
        for (int bj = 0; bj < 2; ++bj)
#pragma unroll
            for (int n = 0; n < 2; ++n) { k1[bj][n] = *(const f32x4*)(c1 + nb + bj * 128 + 4 * n); k2[bj][n] = *(const f32x4*)(c2 + nb + bj * 128 + 4 * n); }
        float frv[8];
#pragma unroll
        for (int i = 0; i < 8; ++i) frv[i] = (pn >= 5 && pn < 9) ? __builtin_amdgcn_exp2f(-(float)(2 * ((colw & 63) + i)) * (13.287712379549449f / 128.f)) * 0.15915494309189535f : 0.f;
#pragma unroll
        for (int ai = 0; ai < 2; ++ai)
#pragma unroll
            for (int m = 0; m < 4; ++m) {
                const int row = u.pm * 256 + ai * 128 + wr * 64 + m * 16 + fr; const int b = row >> 13, t = row & 8191;
                const float2 mr = tab[ai * 128 + wr * 64 + m * 16 + fr]; const float mu = mr.x, rs = mr.y;
                f32x4 v[2][2];
#pragma unroll
                for (int bj = 0; bj < 2; ++bj)
#pragma unroll
                    for (int n = 0; n < 2; ++n) v[bj][n] = (acc[ai][bj][m][n] - k1[bj][n] * mu) * rs + k2[bj][n];
                if (pn < 2) {
#pragma unroll
                    for (int bj = 0; bj < 2; ++bj) *(u32x4*)(qn + (size_t)row * 512 + pn * 256 + bj * 128 + colw) = pack8(v[bj][0] * 0.18033688011112042f, v[bj][1] * 0.18033688011112042f);
                } else if (pn < 5) {
#pragma unroll
                    for (int bj = 0; bj < 2; ++bj) { const int kc = (pn - 2) * 256 + bj * 128 + colw; const int j = kc >> 7, g = (kc >> 6) & 1, d = kc & 63;
                        *(u32x4*)(kv + (size_t)j * KVSZ + ((size_t)((b * 2 + g) * SEQ + t)) * 64 + d) = pack8(v[bj][0], v[bj][1]); }
                } else if (pn < 9) {
                    const bool isk = pn >= 7; const int hp = isk ? pn - 7 : pn - 5; const int hh = colw >> 6, jj = colw & 63, head = 2 * hp + hh;
                    f32x4 cs0, cs1, sn0, sn1; const float tf = (float)t;
#pragma unroll
                    for (int i = 0; i < 4; ++i) { const float r0 = __builtin_amdgcn_fractf(tf * frv[i]), r1 = __builtin_amdgcn_fractf(tf * frv[4 + i]);
                        cs0[i] = __builtin_amdgcn_cosf(r0); sn0[i] = __builtin_amdgcn_sinf(r0); cs1[i] = __builtin_amdgcn_cosf(r1); sn1[i] = __builtin_amdgcn_sinf(r1); }
                    const float sc = isk ? 0.08838834764831845f : 1.f;
                    const f32x4 a0 = (v[0][0] * cs0 - v[1][0] * sn0) * sc, a1 = (v[0][1] * cs1 - v[1][1] * sn1) * sc;
                    const f32x4 b0 = (v[0][0] * sn0 + v[1][0] * cs0) * sc, b1 = (v[0][1] * sn1 + v[1][1] * cs1) * sc;
                    bf16_t* dst = (isk ? kr : qr) + ((size_t)((b * 4 + head) * SEQ + t)) * 128 + jj;
                    *(u32x4*)dst = pack8(a0, a1); *(u32x4*)(dst + 64) = pack8(b0, b1);
                } else if (pn < 11) {
#pragma unroll
                    for (int bj = 0; bj < 2; ++bj) { const int col = (pn - 9) * 256 + bj * 128 + colw; const int head = col >> 7, e = col & 127;
                        *(u32x4*)(vr + ((size_t)((b * 4 + head) * SEQ + t)) * 128 + e) = pack8(v[bj][0], v[bj][1]); }
                } else if (pn < 13) {
#pragma unroll
                    for (int bj = 0; bj < 2; ++bj) *(u32x4*)(sg + (size_t)row * 512 + (pn - 11) * 256 + bj * 128 + colw) = pack8(silu4(v[bj][0]), silu4(v[bj][1]));
                } else {
                    if (wc == 0 && fq < 3) { *(f32x4*)(gates + (size_t)row * 24 + 8 * fq) = sigmoid4(v[0][0]); *(f32x4*)(gates + (size_t)row * 24 + 8 * fq + 4) = sigmoid4(v[0][1]); }
                }
            }
    }
};

struct EpiCmp1 {
    static constexpr bool PERM = true, AFTER_DRAIN = false;
    bf16_t* O; const float* bias;
    __device__ __forceinline__ void operator()(const f32x4 (&acc)[2][2][4][2], const Unit& u, int wr, int wc, int fr, int fq) const {
        const int colw = wc * 32 + 8 * fq;
#pragma unroll
        for (int ai = 0; ai < 2; ++ai)
#pragma unroll
            for (int m = 0; m < 4; ++m) {
                const int row = u.pm * 256 + ai * 128 + wr * 64 + m * 16 + fr;
#pragma unroll
                for (int bj = 0; bj < 2; ++bj) { const int col = bj * 128 + colw;
                    f32x4 a = acc[ai][bj][m][0] + *(const f32x4*)(bias + col), c = acc[ai][bj][m][1] + *(const f32x4*)(bias + col + 4);
                    a = (f32x4){gelu_tanh_f(a[0]), gelu_tanh_f(a[1]), gelu_tanh_f(a[2]), gelu_tanh_f(a[3])}; c = (f32x4){gelu_tanh_f(c[0]), gelu_tanh_f(c[1]), gelu_tanh_f(c[2]), gelu_tanh_f(c[3])};
                    *(u32x4*)(O + (size_t)row * 256 + col) = pack8(a, c); }
            }
    }
};
struct EpiCmp2 {
    static constexpr bool PERM = true, AFTER_DRAIN = false;
    bf16_t* O;
    __device__ __forceinline__ void operator()(const f32x4 (&acc)[2][2][4][2], const Unit& u, int wr, int wc, int fr, int fq) const {
        if (wc >= 2) return;
        const int colw = wc * 32 + 8 * fq;
#pragma unroll
        for (int ai = 0; ai < 2; ++ai)
#pragma unroll
            for (int m = 0; m < 4; ++m) { const int row = u.pm * 256 + ai * 128 + wr * 64 + m * 16 + fr;
                *(u32x4*)(O + (size_t)row * 64 + colw) = pack8(acc[ai][0][m][0], acc[ai][0][m][1]); }
    }
};
struct EpiPlain {
    static constexpr bool PERM = true, AFTER_DRAIN = false; static constexpr int ldc = 1024;
    bf16_t* O;
    __device__ __forceinline__ void operator()(const f32x4 (&acc)[2][2][4][2], const Unit& u, int wr, int wc, int fr, int fq) const {
        const int colw = wc * 32 + 8 * fq;
#pragma unroll
        for (int ai = 0; ai < 2; ++ai)
#pragma unroll
            for (int m = 0; m < 4; ++m) { const int row = u.pm * 256 + ai * 128 + wr * 64 + m * 16 + fr;
#pragma unroll
                for (int bj = 0; bj < 2; ++bj) *(u32x4*)(O + (size_t)row * ldc + u.pn * 256 + bj * 128 + colw) = pack8(acc[ai][bj][m][0], acc[ai][bj][m][1]);
                asm volatile("" ::: "memory"); }
    }
};
struct EpiGate {
    static constexpr bool PERM = true, AFTER_DRAIN = false;
    float* yf; const bf16_t* xb; const bf16_t* pe; float* st_out; const float* st_in; const float* lg; const float* lb; const float* c1; const float* c2; float2* tab;
    __device__ __forceinline__ void operator()(const f32x4 (&acc)[2][2][4][2], const Unit& u, int wr, int wc, int fr, int fq) const {
        const int colw = wc * 32 + 8 * fq, nb = u.pn * 256 + colw;
        panel_stats(st_in, u.pm, tab);
#pragma unroll
        for (int ai = 0; ai < 2; ++ai)
#pragma unroll
            for (int m = 0; m < 4; ++m) {
                const int row = u.pm * 256 + ai * 128 + wr * 64 + m * 16 + fr;
                u32x4 xw[2], pw[2];
#pragma unroll
                for (int bj = 0; bj < 2; ++bj) { const size_t off = (size_t)row * DM + nb + bj * 128; xw[bj] = *(const u32x4*)(xb + off); pw[bj] = *(const u32x4*)(pe + off); }
                const float2 mr = tab[ai * 128 + wr * 64 + m * 16 + fr]; const float mu = mr.x, rs = mr.y;
                float s = 0.f, q = 0.f;
#pragma unroll
                for (int bj = 0; bj < 2; ++bj) {
                    const int col = nb + bj * 128; const size_t off = (size_t)row * DM + col;
#pragma unroll
                    for (int n = 0; n < 2; ++n) {
                        const f32x4 k1 = *(const f32x4*)(c1 + col + 4 * n), k2 = *(const f32x4*)(c2 + col + 4 * n), gv = *(const f32x4*)(lg + col + 4 * n), bv = *(const f32x4*)(lb + col + 4 * n);
                        const f32x4 gt = sigmoid4((acc[ai][bj][m][n] - k1 * mu) * rs + k2);
                        const unsigned pa = n ? pw[bj].z : pw[bj].x, pb = n ? pw[bj].w : pw[bj].y, xa = n ? xw[bj].z : xw[bj].x, xc = n ? xw[bj].w : xw[bj].y;
                        const f32x4 e = (f32x4){bflo(pa), bfhi(pa), bflo(pb), bfhi(pb)} * gt;
                        const f32x4 x = ((f32x4){bflo(xa), bfhi(xa), bflo(xc), bfhi(xc)} - mu) * rs * gv + bv;
                        const f32x4 y = x * ALPHA + e;
                        *(f32x4*)(yf + off + 4 * n) = y;
                        s += hsum4(y); q += hsum4(y * y);
                    }
                }
                s = xsum32(xsum16(s)); q = xsum32(xsum16(q));
                if (fq == 0) *(float2*)(st_out + (size_t)row * 32 + (u.pn * 4 + wc) * 2) = make_float2(s, q);
            }
    }
};
struct OneUnit {
    int pm; bool on;
    __device__ __forceinline__ bool next(int i, Unit& u) const { if (i != 0 || !on) return false; u.pm = pm; u.pn = 0; return true; }
    __device__ __forceinline__ void a_ready(const Unit&) const {}
    __device__ __forceinline__ void done(const Unit&) const {}
};

struct MatDesc { const float* W; bf16_t* Bt; const float* gk; const float* bk; int K, N, Np, map, mode, cbase; };
__device__ __forceinline__ int map_col(int map, int n) {
    if (map == 0) { const int tile = n >> 8, w = n & 255; return (w >> 7) * DFF + tile * 128 + (w & 127); }
    if (map == 1) return n;
    if (map == 2) {
        const int pn = n >> 8, w = n & 255;
        if (pn < 5) return n;
        if (pn < 9) { const int base = (pn < 7) ? 1304 : 1816; const int hp = (pn < 7) ? pn - 5 : pn - 7; const int bj = w >> 7, hh = (w >> 6) & 1, jj = w & 63; return base + (2 * hp + hh) * 128 + 64 * bj + jj; }
        if (pn < 11) return 2328 + (n - 9 * 256);
        if (pn < 13) return 2840 + (n - 11 * 256);
        return (w < 24) ? 1280 + w : -1;
    }
    return (n < 64) ? n : -1;
}
__device__ __forceinline__ MatDesc get_mat(const Args& a, int id) {
    bf16_t* wb = (bf16_t*)(a.ws + OFF_W); const float* lng = a.in[13];
    MatDesc d;
    const float* lnb = a.in[14];
    switch (id) {
    case 0: d = MatDesc{a.in[2], wb + W_13A, nullptr, nullptr, 1024, 5632, 5632, 0, 0, 0}; break;
    case 1: d = MatDesc{a.in[2] + (size_t)1024 * 5632, wb + W_13B, lng + 1024, lnb + 1024, 1024, 5632, 5632, 0, 1, NINP}; break;
    case 2: d = MatDesc{a.in[3], wb + W_2A, nullptr, nullptr, 2816, 1024, 1024, 1, 0, 0}; break;
    case 3: d = MatDesc{a.in[3] + (size_t)2816 * 1024, wb + W_2B, nullptr, nullptr, 2816, 1024, 1024, 1, 0, 0}; break;
    case 4: d = MatDesc{a.in[4], wb + W_IN, lng, lnb, 1024, NIN, NINP, 2, 1, 0}; break;
    case 5: d = MatDesc{a.in[6], wb + W_C1K, nullptr, a.in[5], 2048, 256, 256, 1, 2, 0}; break;
    case 6: d = MatDesc{a.in[6] + 2048 * 256, wb + W_C1V, nullptr, a.in[5] + 2048, 2048, 256, 256, 1, 2, 256}; break;
    case 7: d = MatDesc{a.in[7], wb + W_C2K, nullptr, nullptr, 256, 64, 256, 3, 0, 0}; break;
    case 8: d = MatDesc{a.in[7] + 256 * 64, wb + W_C2V, nullptr, nullptr, 256, 64, 256, 3, 0, 0}; break;
    case 9: d = MatDesc{a.in[10], wb + W_OUT, nullptr, nullptr, 1024, 1024, 1024, 1, 0, 0}; break;
    case 10: d = MatDesc{a.in[11], wb + W_PLE, nullptr, nullptr, 256, 1024, 1024, 1, 0, 0}; break;
    default: d = MatDesc{a.in[12], wb + W_PG, lng + 2048, lnb + 2048, 1024, 1024, 1024, 1, 1, NINP + 5632}; break;
    }
    return d;
}
__device__ __forceinline__ void titem_load(const MatDesc& d, int item, int lane, f32x4 (&wv)[8]) {
    const int nblk = d.Np / 32, kb = item / nblk, nb = item % nblk, k0 = 64 * kb, n0 = 32 * nb;
    const int c4 = (lane & 7) * 4, kr = lane >> 3;
    const int sc = map_col(d.map, n0 + c4);
#pragma unroll
    for (int i = 0; i < 8; ++i) { const int kk = 8 * i + kr; wv[i] = (sc >= 0) ? *(const f32x4*)(d.W + (size_t)(k0 + kk) * d.N + sc) : (f32x4){0.f, 0.f, 0.f, 0.f}; }
}
__device__ __forceinline__ void titem_finish(const MatDesc& d, float* scr, float* vec, int item, int lane, const f32x4 (&wv)[8]) {
    const int nblk = d.Np / 32, kb = item / nblk, nb = item % nblk, k0 = 64 * kb, n0 = 32 * nb;
    const int c4 = (lane & 7) * 4, kr = lane >> 3;
    f32x4 s1 = {0.f, 0.f, 0.f, 0.f}, s2 = {0.f, 0.f, 0.f, 0.f};
#pragma unroll
    for (int i = 0; i < 8; ++i) { const int kk = 8 * i + kr;
        f32x4 w = wv[i];
        if (d.mode == 1) { const f32x4 wg = w * d.gk[k0 + kk]; s1 += (f32x4){bfround(wg[0]), bfround(wg[1]), bfround(wg[2]), bfround(wg[3])}; s2 += w * d.bk[k0 + kk]; w = wg; }
        else if (d.mode == 2) s1 += w * d.bk[k0 + kk];
        float* sp = scr + kk * 33 + c4; sp[0] = w[0]; sp[1] = w[1]; sp[2] = w[2]; sp[3] = w[3]; }
    if (d.mode != 0) {
#pragma unroll
        for (int e = 0; e < 4; ++e) { s1[e] += __shfl_xor(s1[e], 8); s1[e] += __shfl_xor(s1[e], 16); s1[e] += __shfl_xor(s1[e], 32); s2[e] += __shfl_xor(s2[e], 8); s2[e] += __shfl_xor(s2[e], 16); s2[e] += __shfl_xor(s2[e], 32); }
        if (lane < 8) {
            if (d.mode == 1) { float* cp = vec + V_CPART + ((size_t)kb * NCV + d.cbase + n0 + c4) * 2;
#pragma unroll
                for (int e = 0; e < 4; ++e) { cp[2 * e] = s1[e]; cp[2 * e + 1] = s2[e]; } }
            else *(f32x4*)(vec + V_CBP + kb * 512 + d.cbase + n0 + c4) = s1; } }
    __builtin_amdgcn_fence(__ATOMIC_RELEASE, "workgroup"); __builtin_amdgcn_wave_barrier(); __builtin_amdgcn_fence(__ATOMIC_ACQUIRE, "workgroup");
    const int c = lane & 7;
#pragma unroll
    for (int j = 0; j < 4; ++j) { const int n = (lane >> 3) + 8 * j; const float* s = scr + (8 * c) * 33 + n;
        u32x4 o; o.x = pg8::cvt_pk_bf16(s[0 * 33], s[1 * 33]); o.y = pg8::cvt_pk_bf16(s[2 * 33], s[3 * 33]); o.z = pg8::cvt_pk_bf16(s[4 * 33], s[5 * 33]); o.w = pg8::cvt_pk_bf16(s[6 * 33], s[7 * 33]);
        *(u32x4*)(d.Bt + (size_t)(n0 + n) * d.K + k0 + 8 * c) = o; }
    __builtin_amdgcn_fence(__ATOMIC_RELEASE, "workgroup"); __builtin_amdgcn_wave_barrier(); __builtin_amdgcn_fence(__ATOMIC_ACQUIRE, "workgroup");
}
__device__ __forceinline__ void prep_phase(const Args& a, unsigned char* lds) {
    int tid_ = threadIdx.x; asm volatile("" : "+v"(tid_));
    const int tid = tid_, lane = tid & 63, wave = tid >> 6;
    const int gw = blockIdx.x * 8 + wave, NGW = gridDim.x * 8;
    const int gtid = blockIdx.x * NTHREADS + tid, gsz = gridDim.x * NTHREADS;
    float* scr = (float*)(lds + wave * 16384);
    {
        const int cnt[12] = {2816, 2816, 1408, 1408, 1792, 256, 256, 32, 32, 512, 128, 512};
        int total = 0;
#pragma unroll
        for (int i = 0; i < 12; ++i) total += cnt[i];
        int it = gw, rc = 0, idc = 0; f32x4 wa[8];
        if (it < total) { rc = it;
#pragma unroll
            for (int i = 0; i < 11; ++i) { if (idc == i && rc >= cnt[i]) { rc -= cnt[i]; idc = i + 1; } }
            titem_load(get_mat(a, idc), rc, lane, wa); }
        for (; it < total; it += NGW) {
            const int nx = it + NGW; int rn = nx, idn = 0; f32x4 wn[8];
            if (nx < total) {
#pragma unroll
                for (int i = 0; i < 11; ++i) { if (idn == i && rn >= cnt[i]) { rn -= cnt[i]; idn = i + 1; } }
                titem_load(get_mat(a, idn), rn, lane, wn); }
            titem_finish(get_mat(a, idc), scr, (float*)(a.ws + OFF_VEC), rc, lane, wa);
            rc = rn; idc = idn;
#pragma unroll
            for (int i = 0; i < 8; ++i) wa[i] = wn[i];
        }
    }
    {
        const f32x4* x4 = (const f32x4*)a.in[0]; u32x4* xb = (u32x4*)(a.ws + OFF_YB);
        for (size_t i = gtid; i < (size_t)M * DM / 8; i += (size_t)8 * gsz) { f32x4 v[16];
#pragma unroll
            for (int k = 0; k < 8; ++k) { const size_t j = i + (size_t)k * gsz; const bool ok = j < (size_t)M * DM / 8; v[2 * k] = ok ? x4[2 * j] : (f32x4){0.f, 0.f, 0.f, 0.f}; v[2 * k + 1] = ok ? x4[2 * j + 1] : (f32x4){0.f, 0.f, 0.f, 0.f}; }
#pragma unroll
            for (int k = 0; k < 8; ++k) { const size_t j = i + (size_t)k * gsz; if (j < (size_t)M * DM / 8) xb[j] = pack8(v[2 * k], v[2 * k + 1]); } }
        const f32x4* p4 = (const f32x4*)a.in[1]; u32x4* pb = (u32x4*)(a.ws + OFF_PB);
        for (size_t i = gtid; i < (size_t)M * PLE / 8; i += (size_t)8 * gsz) { f32x4 v[16];
#pragma unroll
            for (int k = 0; k < 8; ++k) { const size_t j = i + (size_t)k * gsz; const bool ok = j < (size_t)M * PLE / 8; v[2 * k] = ok ? p4[2 * j] : (f32x4){0.f, 0.f, 0.f, 0.f}; v[2 * k + 1] = ok ? p4[2 * j + 1] : (f32x4){0.f, 0.f, 0.f, 0.f}; }
#pragma unroll
            for (int k = 0; k < 8; ++k) { const size_t j = i + (size_t)k * gsz; if (j < (size_t)M * PLE / 8) pb[j] = pack8(v[2 * k], v[2 * k + 1]); } }
    }
}
__device__ __forceinline__ void reduce_vec_phase(const Args& a) {
    int tid_ = threadIdx.x; asm volatile("" : "+v"(tid_));
    const int gtid = blockIdx.x * NTHREADS + tid_, gsz = gridDim.x * NTHREADS;
    float* vec = (float*)(a.ws + OFF_VEC);
    for (int col = gtid; col < NCV; col += gsz) { float s1 = 0.f, s2 = 0.f;
#pragma unroll
        for (int ks = 0; ks < 16; ++ks) { s1 += vec[V_CPART + ((size_t)ks * NCV + col) * 2]; s2 += vec[V_CPART + ((size_t)ks * NCV + col) * 2 + 1]; }
        vec[V_C1 + col] = s1; vec[V_C2 + col] = s2; }
    for (int i = gtid; i < 512; i += gsz) { float s = 0.f;
#pragma unroll
        for (int ks = 0; ks < 32; ++ks) s += vec[V_CBP + ks * 512 + i];
        vec[V_CB + i] = s; }
}

__device__ __forceinline__ float ret_log_gamma(int h) { return __logf(1.f - __builtin_amdgcn_exp2f(-5.f - (float)h)); }
namespace nsa {
typedef short bf16x8 __attribute__((ext_vector_type(8)));
typedef short s16x4 __attribute__((ext_vector_type(4)));
typedef float f32x16 __attribute__((ext_vector_type(16)));
typedef float f32x2_t __attribute__((ext_vector_type(2)));
typedef __bf16 bf16x2_t __attribute__((ext_vector_type(2)));
typedef short v4i16_t __attribute__((ext_vector_type(4)));
#define NLAS __attribute__((address_space(3)))
typedef NLAS const char* lds_cptr;
#define MFMA32(a, b, c) __builtin_amdgcn_mfma_f32_32x32x16_bf16((a), (b), (c), 0, 0, 0)
constexpr int L_K = 0, L_V = 16384, IMP_P = 132, L_SELM = 65536, L_WSF = L_SELM + 1024, L_OST = L_WSF + 8 * 512, L_IMP = L_OST, L_END = L_OST + 8 * 8192;
static_assert(L_END <= LDS_BYTES, "nsa LDS map");
constexpr float THR = 8.f;
__device__ __forceinline__ int crow(int r, int hi) { return (r & 3) + 8 * (r >> 2) + 4 * hi; }
__device__ __forceinline__ unsigned cvtpk(float lo, float hi) { f32x2_t v = {lo, hi}; bf16x2_t b = __builtin_convertvector(v, bf16x2_t); return __builtin_bit_cast(unsigned, b); }
__device__ __forceinline__ s16x4 vtr(lds_cptr p) { return __builtin_bit_cast(s16x4, __builtin_amdgcn_ds_read_tr16_b64_v4i16((NLAS v4i16_t*)p)); }
__device__ __forceinline__ float swapmax(float a) { auto rr = __builtin_amdgcn_permlane32_swap(__float_as_uint(a), __float_as_uint(a), false, false); return fmaxf(__uint_as_float(rr[0]), __uint_as_float(rr[1])); }
__device__ __forceinline__ float swapsum(float a) { auto rr = __builtin_amdgcn_permlane32_swap(__float_as_uint(a), __float_as_uint(a), false, false); return __uint_as_float(rr[0]) + __uint_as_float(rr[1]); }
__device__ __forceinline__ void kload(bf16x8 (&kf)[8], lds_cptr kb) {
#pragma unroll
    for (int d0 = 0; d0 < 4; ++d0) { kf[2 * d0] = *(const NLAS bf16x8*)(kb + d0 * 2048); kf[2 * d0 + 1] = *(const NLAS bf16x8*)(kb + d0 * 2048 + 512); }
}
__device__ __forceinline__ void vload(bf16x8 (&vf)[8], lds_cptr vp) {
#pragma unroll
    for (int d0 = 0; d0 < 2; ++d0)
#pragma unroll
        for (int ks = 0; ks < 4; ++ks) { const s16x4 lo = vtr(vp + d0 * 4096 + ks * 1024), hi = vtr(vp + d0 * 4096 + ks * 1024 + 512); vf[4 * d0 + ks] = __builtin_shufflevector(lo, hi, 0, 1, 2, 3, 4, 5, 6, 7); }
}
__device__ __forceinline__ void qkt_f(f32x16& p0, f32x16& p1, const bf16x8 (&kf)[8], const bf16x8 (&qr)[4]) {
    f32x16 z;
#pragma unroll
    for (int i = 0; i < 16; ++i) z[i] = 0.f;
    __builtin_amdgcn_s_setprio(1);
    p0 = MFMA32(kf[0], qr[0], z); p1 = MFMA32(kf[1], qr[0], z);
#pragma unroll
    for (int d0 = 1; d0 < 4; ++d0) { p0 = MFMA32(kf[2 * d0], qr[d0], p0); p1 = MFMA32(kf[2 * d0 + 1], qr[d0], p1); }
    __builtin_amdgcn_s_setprio(0);
}
__device__ __forceinline__ void pvmul_f(f32x16 (&o)[2], const bf16x8 (&vf)[8], const u32x4 (&pw)[4]) {
    __builtin_amdgcn_s_setprio(1);
#pragma unroll
    for (int ks = 0; ks < 4; ++ks) { o[0] = MFMA32(__builtin_bit_cast(bf16x8, pw[ks]), vf[ks], o[0]); o[1] = MFMA32(__builtin_bit_cast(bf16x8, pw[ks]), vf[4 + ks], o[1]); }
    __builtin_amdgcn_s_setprio(0);
}
__device__ __forceinline__ void qkt(f32x16& p0, f32x16& p1, lds_cptr kb, const bf16x8 (&qr)[4]) {
    bf16x8 kf[8]; kload(kf, kb); __builtin_amdgcn_sched_barrier(0); qkt_f(p0, p1, kf, qr);
}
__device__ __forceinline__ void packp(u32x4 (&pw)[4], const f32x16& p0, const f32x16& p1) {
    pw[0] = (u32x4){cvtpk(p0[0], p0[1]), cvtpk(p0[2], p0[3]), cvtpk(p0[4], p0[5]), cvtpk(p0[6], p0[7])};
    pw[1] = (u32x4){cvtpk(p0[8], p0[9]), cvtpk(p0[10], p0[11]), cvtpk(p0[12], p0[13]), cvtpk(p0[14], p0[15])};
    pw[2] = (u32x4){cvtpk(p1[0], p1[1]), cvtpk(p1[2], p1[3]), cvtpk(p1[4], p1[5]), cvtpk(p1[6], p1[7])};
    pw[3] = (u32x4){cvtpk(p1[8], p1[9]), cvtpk(p1[10], p1[11]), cvtpk(p1[12], p1[13]), cvtpk(p1[14], p1[15])};
}
__device__ __forceinline__ void pvmul(f32x16 (&o)[2], lds_cptr vp, const u32x4 (&pw)[4]) {
    bf16x8 vf[8]; vload(vf, vp); __builtin_amdgcn_sched_barrier(0); pvmul_f(o, vf, pw);
}
__device__ __forceinline__ float fsub_s(float a, float b) { float r; asm("v_sub_f32_e32 %0, %1, %2" : "=v"(r) : "v"(a), "v"(b)); return r; }
__device__ __forceinline__ float max3f(float a, float b, float c) { float r; asm("v_max3_f32 %0, %1, %2, %3" : "=v"(r) : "v"(a), "v"(b), "v"(c)); return r; }
__device__ __forceinline__ float max2f(float a, float b) { float r; asm("v_max_f32_e32 %0, %1, %2" : "=v"(r) : "v"(a), "v"(b)); return r; }
__device__ __forceinline__ void mfma_guard(f32x16& a, f32x16& b) { asm volatile("s_nop 15\n\ts_nop 7" : "+v"(a), "+v"(b)); }
__device__ __forceinline__ float sub_rowmax(f32x16& p0, f32x16& p1, float ref) {
#pragma unroll
    for (int r = 0; r < 16; ++r) { p0[r] = fsub_s(p0[r], ref); p1[r] = fsub_s(p1[r], ref); }
    float a = max3f(p0[0], p0[1], p1[0]), b = max3f(p0[2], p0[3], p1[1]); a = max3f(a, p1[2], p1[3]);
#pragma unroll
    for (int r = 4; r < 16; r += 4) { a = max3f(a, p0[r], p0[r + 1]); b = max3f(b, p0[r + 2], p0[r + 3]); a = max3f(a, p1[r], p1[r + 1]); b = max3f(b, p1[r + 2], p1[r + 3]); }
    return swapmax(max2f(a, b));
}
__device__ __forceinline__ void maskp(f32x16& p0, f32x16& p1, int lo, int hl, int hi) {
    const float NINF = -__builtin_inff();
    int la = lo - 4 * hi, ha = hl - 4 * hi;
    asm volatile("" : "+v"(la), "+v"(ha));
#pragma unroll
    for (int r = 0; r < 16; ++r) { const int cr = (r & 3) + 8 * (r >> 2);
        p0[r] = (cr >= la && cr <= ha) ? p0[r] : NINF; p1[r] = (cr + 32 >= la && cr + 32 <= ha) ? p1[r] : NINF; }
}
__device__ __forceinline__ float rowmax_a(const f32x16& p0, const f32x16& p1) {
    float a = max3f(p0[0], p0[1], p1[0]), b = max3f(p0[2], p0[3], p1[1]); a = max3f(a, p1[2], p1[3]);
#pragma unroll
    for (int r = 4; r < 16; r += 4) { a = max3f(a, p0[r], p0[r + 1]); b = max3f(b, p0[r + 2], p0[r + 3]); a = max3f(a, p1[r], p1[r + 1]); b = max3f(b, p1[r + 2], p1[r + 3]); }
    return swapmax(max2f(a, b));
}
__device__ __forceinline__ float rowmax32(const f32x16& p0, const f32x16& p1) {
    float a = fmaxf(p0[0], p1[0]);
#pragma unroll
    for (int r = 1; r < 16; ++r) a = fmaxf(a, fmaxf(p0[r], p1[r]));
    return swapmax(a);
}
__device__ __forceinline__ void softmax_rel(f32x16& p0, f32x16& p1, float& m, float& l, f32x16 (&o)[2], float* wsf, int r32, int hi, bool en, bool first) {
    mfma_guard(p0, p1);
    if (first) { const float rm0 = rowmax32(p0, p1); m = (rm0 > -3e38f) ? rm0 : 0.f; }
    const float rm = sub_rowmax(p0, p1, en ? m : __builtin_inff());
    if (__any(rm > THR)) {
        const float dl = fmaxf(rm, 0.f), al = __builtin_amdgcn_exp2f(-dl);
        m += dl; l *= al;
#pragma unroll
        for (int r = 0; r < 16; ++r) { p0[r] -= dl; p1[r] -= dl; }
        if (hi == 0) wsf[r32] = al;
        asm volatile("s_waitcnt lgkmcnt(0)" ::: "memory");
#pragma unroll
        for (int r = 0; r < 16; ++r) { const float f = wsf[4 * hi + (r & 3) + 8 * (r >> 2)]; o[0][r] *= f; o[1][r] *= f; }
        asm volatile("s_waitcnt lgkmcnt(0)" ::: "memory");
    }
    float s = 0.f;
#pragma unroll
    for (int r = 0; r < 16; ++r) { p0[r] = __builtin_amdgcn_exp2f(p0[r]); s += p0[r]; p1[r] = __builtin_amdgcn_exp2f(p1[r]); s += p1[r]; }
    l += s;
}
__device__ __forceinline__ void stats_rel(f32x16& p0, f32x16& p1, float& m, float& l, bool first) {
    mfma_guard(p0, p1);
    if (first) { const float rm0 = rowmax32(p0, p1); m = (rm0 > -3e38f) ? rm0 : 0.f; }
    const float rm = sub_rowmax(p0, p1, m);
    if (__any(rm > THR)) {
        const float dl = fmaxf(rm, 0.f); m += dl; l *= __builtin_amdgcn_exp2f(-dl);
#pragma unroll
        for (int r = 0; r < 16; ++r) { p0[r] -= dl; p1[r] -= dl; }
    }
    float s = 0.f;
#pragma unroll
    for (int r = 0; r < 16; ++r) { s += __builtin_amdgcn_exp2f(p0[r]); s += __builtin_amdgcn_exp2f(p1[r]); }
    l += s;
}
__device__ __forceinline__ void glds16(const void* gsrc, unsigned lds_dst) { unsigned keep;
    asm volatile("s_mov_b32 %0, m0\n\ts_mov_b32 m0, %2\n\ts_nop 0\n\tglobal_load_lds_dwordx4 %1, off\n\ts_mov_b32 m0, %0" : "=&s"(keep) : "v"(gsrc), "s"(lds_dst) : "memory"); }
__device__ __forceinline__ int nsa_ksoff() { int t_ = threadIdx.x; asm volatile("" : "+v"(t_)); return (t_ & 63) * 64 + (t_ >> 6) * 8; }
__device__ __forceinline__ int nsa_vsoff() { int t_ = threadIdx.x; asm volatile("" : "+v"(t_)); const int l_ = t_ & 63, w_ = t_ >> 6; return (16 * (w_ & 3) + (l_ >> 2)) * 64 + (w_ >> 2) * 32 + (l_ & 3) * 8; }
__device__ __forceinline__ float nsa_gate(const float* gates, int b, int t0, int g, int k) {
    int t_ = threadIdx.x; asm volatile("" : "+v"(t_));
    const int r32_ = t_ & 31, w_ = t_ >> 6;
    return gates[((size_t)b * SEQ + t0 + 8 * w_ + (r32_ >> 2)) * 24 + g * 12 + (r32_ & 3) * 3 + k];
}
struct Ptrs { const bf16_t* qn; const bf16_t* kv; const bf16_t* kcmp; const float* gates; bf16_t* mix; };

__device__ __forceinline__ void unit(const Ptrs& P, int bg, int it, unsigned char* lds, NLAS unsigned char* lds3) {
    int tid_ = threadIdx.x; asm volatile("" : "+v"(tid_));
    const int tid = tid_, lane = tid & 63, wid = __builtin_amdgcn_readfirstlane(tid >> 6), r32 = lane & 31, hi = lane >> 5;
    const int b = bg >> 1, g = bg & 1, t0 = it * 64, cur = it;
    const int tl = 8 * wid + (r32 >> 2), head = r32 & 3;
    const size_t rowg = (size_t)b * SEQ + t0 + tl;
    bf16x8 qr[4];
    { const bf16_t* qp = P.qn + rowg * 512 + g * 256 + head * 64 + hi * 8;
#pragma unroll
      for (int d0 = 0; d0 < 4; ++d0) qr[d0] = *(const bf16x8*)(qp + d0 * 16); }
    const lds_cptr kb0 = (lds_cptr)lds3 + L_K + hi * 1024 + r32 * 16;
    const lds_cptr vp0 = (lds_cptr)lds3 + L_V + ((lane >> 4) & 1) * 32 + (lane & 3) * 8 + (4 * hi + ((lane & 15) >> 2)) * 64;
    float* wsf = (float*)(lds + L_WSF + wid * 512);
    float* ost = (float*)(lds + L_OST + wid * 8192);
    float* imp = (float*)(lds + L_IMP);
    unsigned short* selm = (unsigned short*)(lds + L_SELM);
#define ksoff nsa_ksoff()
#define vsoff nsa_vsoff()
#define NSA_GT(k) nsa_gate(P.gates, b, t0, g, (k))
    const unsigned dma0 = (unsigned)(uintptr_t)lds + wid * 1024;
#define NSA_DMA2(Kb, Vb, tile, two, slot) do { const unsigned d_ = (unsigned)__builtin_amdgcn_readfirstlane(dma0 + (slot) * 32768); \
        glds16((Kb) + (size_t)(tile) * 4096 + ksoff, d_); glds16((Vb) + (size_t)(tile) * 4096 + vsoff, d_ + 16384); \
        if (two) { glds16((Kb) + (size_t)((tile) + 1) * 4096 + ksoff, d_ + 8192); glds16((Vb) + (size_t)((tile) + 1) * 4096 + vsoff, d_ + 24576); } } while (0)
#define NSA_DMAWAIT() asm volatile("s_waitcnt vmcnt(0)" ::: "memory")
#define NSA_COMBINE(first, facv) do { if (hi == 0) wsf[32 + r32] = (facv); asm volatile("s_waitcnt lgkmcnt(0)" ::: "memory"); \
        { const float* wb_ = wsf + 32 + 4 * hi; float* ob_ = ost + 256 * hi + r32; \
        _Pragma("unroll") for (int r = 0; r < 16; ++r) { const float f_ = wb_[(r & 3) + 8 * (r >> 2)]; \
            _Pragma("unroll") for (int d0 = 0; d0 < 2; ++d0) { float* op_ = ob_ + ((r & 3) + 8 * (r >> 2)) * 64 + 32 * d0; *op_ = ((first) ? 0.f : *op_) + o[d0][r] * f_; } } } \
        asm volatile("s_waitcnt lgkmcnt(0)" ::: "memory"); } while (0)

#define NSA_COMBINE_L(facv, lsv) do { if (hi == 0) wsf[32 + r32] = (facv); asm volatile("s_waitcnt lgkmcnt(0)" ::: "memory"); \
        { const float* wb_ = wsf + 32 + 4 * hi; float* ob_ = ost + 256 * hi + r32; \
        _Pragma("unroll") for (int r = 0; r < 16; ++r) { const float f_ = wb_[(r & 3) + 8 * (r >> 2)] * __builtin_amdgcn_rcpf(lsv[r]); \
            _Pragma("unroll") for (int d0 = 0; d0 < 2; ++d0) { float* op_ = ob_ + ((r & 3) + 8 * (r >> 2)) * 64 + 32 * d0; *op_ = *op_ + o[d0][r] * f_; } } } \
        asm volatile("s_waitcnt lgkmcnt(0)" ::: "memory"); } while (0)
    f32x16 o[2], p0, p1; u32x4 pw[4];
    const bf16_t* Kc = P.kcmp + (size_t)bg * 512 * 64; const bf16_t* Vc = Kc + KCMP_J;
    {
        const int t = t0 + tl; const int ncl = (t >= 31) ? ((t - 31) >> 4) + 1 : 0;
        const int NT = (4 * it + 3 + 63) >> 6, NI = (NT + 1) >> 1;
        float m = 0.f, l = 0.f;
        NSA_DMA2(Kc, Vc, 0, NT > 1, 0); NSA_DMAWAIT(); __syncthreads();
        for (int n = 0; n < NI; ++n) {
            const int slot = n & 1;
            if (n + 1 < NI) NSA_DMA2(Kc, Vc, 2 * n + 2, 2 * n + 3 < NT, slot ^ 1);
#pragma unroll
            for (int sub = 0; sub < 2; ++sub) {
                const int jb = 2 * n + sub;
                if (jb < NT) {
                    qkt(p0, p1, kb0 + slot * 32768 + sub * 8192, qr);
                    if (__any(ncl - 64 * jb < 64)) maskp(p0, p1, 0, ncl - 64 * jb - 1, hi);
                    stats_rel(p0, p1, m, l, jb == 0);
                }
            }
            NSA_DMAWAIT(); __syncthreads();
        }
        l = swapsum(l);
        const float m2 = (l > 0.f) ? m + __builtin_amdgcn_logf(l) : m;
        for (int i = lane; i < 8 * IMP_P; i += 64) imp[8 * wid * IMP_P + i] = 0.f;
        bf16x8 ovf[4];
#pragma unroll
        for (int ks = 0; ks < 4; ++ks)
#pragma unroll
            for (int j = 0; j < 8; ++j) { const int k4 = 4 * ks + 2 * (j >> 2) + hi, pos = j & 3;
                ovf[ks][j] = (short)((r32 == k4) ? ((pos == 3) ? 0x3F00 : 0x3F80) : ((r32 == k4 + 1 && pos == 3) ? 0x3F00 : 0)); }
#pragma unroll
        for (int i = 0; i < 16; ++i) { o[0][i] = 0.f; o[1][i] = 0.f; }
        NSA_DMA2(Kc, Vc, 0, NT > 1, 0); NSA_DMAWAIT(); __syncthreads();
        for (int n = 0; n < NI; ++n) {
            const int slot = n & 1;
            if (n + 1 < NI) NSA_DMA2(Kc, Vc, 2 * n + 2, 2 * n + 3 < NT, slot ^ 1);
#pragma unroll
            for (int sub = 0; sub < 2; ++sub) {
                const int jb = 2 * n + sub;
                if (jb < NT) {
                    qkt(p0, p1, kb0 + slot * 32768 + sub * 8192, qr);
                    if (__any(ncl - 64 * jb < 64)) maskp(p0, p1, 0, ncl - 64 * jb - 1, hi);
                    mfma_guard(p0, p1);
#pragma unroll
                    for (int r = 0; r < 16; ++r) { p0[r] = __builtin_amdgcn_exp2f(fsub_s(p0[r], m2)); p1[r] = __builtin_amdgcn_exp2f(fsub_s(p1[r], m2)); }
                    packp(pw, p0, p1);
                    pvmul(o, vp0 + slot * 32768 + sub * 8192, pw);
                    if (cur >= 16) {
                        f32x16 ia;
#pragma unroll
                        for (int i = 0; i < 16; ++i) ia[i] = 0.f;
#pragma unroll
                        for (int ks = 0; ks < 4; ++ks) ia = MFMA32(__builtin_bit_cast(bf16x8, pw[ks]), ovf[ks], ia);
                        if (r32 <= 16) {
                            { float* ib = imp + (8 * wid + hi) * IMP_P + jb * 16 + r32;
#pragma unroll
                            for (int i = 0; i < 4; ++i) ib[2 * i * IMP_P] += (ia[4 * i] + ia[4 * i + 1]) + (ia[4 * i + 2] + ia[4 * i + 3]); }
                        }
                    }
                }
            }
            NSA_DMAWAIT(); __syncthreads();
        }
    }
    {
        const bf16_t* ks_ = P.kv + 2 * KVSZ + (size_t)bg * SEQ * 64 + ksoff; const bf16_t* vs_ = P.kv + 3 * KVSZ + (size_t)bg * SEQ * 64 + vsoff;
        glds16(ks_, (unsigned)__builtin_amdgcn_readfirstlane(dma0)); glds16(vs_, (unsigned)__builtin_amdgcn_readfirstlane(dma0 + 24576));
        if (cur > 0) glds16(ks_ + 4096, (unsigned)__builtin_amdgcn_readfirstlane(dma0 + 8192));
        if (cur > 1) glds16(ks_ + 8192, (unsigned)__builtin_amdgcn_readfirstlane(dma0 + 16384));
    }
    {
        const int j = lane >> 3, sub = lane & 7, tok = 8 * wid + j;
        unsigned key[16];
#pragma unroll
        for (int i = 0; i < 16; ++i) { const int s = sub * 16 + i; const float v = imp[tok * IMP_P + s];
            const bool forced = (s == 0) | (s == cur) | (s == cur - 1);
            key[i] = (s > cur) ? 0u : (forced ? (0x7F800000u | (unsigned)(127 - s)) : ((__float_as_uint(v) & 0xFFFFFF80u) | (unsigned)(127 - s))); }
        unsigned selbits = 0u;
        if (cur < 16) {
#pragma unroll
            for (int i = 0; i < 16; ++i) selbits |= (key[i] != 0u) ? (1u << i) : 0u;
        } else {
#pragma nounroll
            for (int itr = 0; itr < 16; ++itr) {
                unsigned mx = key[0];
#pragma unroll
                for (int i = 1; i < 16; ++i) mx = key[i] > mx ? key[i] : mx;
                { unsigned w = (unsigned)__builtin_amdgcn_update_dpp(0, (int)mx, 0xB1, 0xF, 0xF, false); mx = w > mx ? w : mx;
                  w = (unsigned)__builtin_amdgcn_update_dpp(0, (int)mx, 0x4E, 0xF, 0xF, false); mx = w > mx ? w : mx;
                  w = (unsigned)__builtin_amdgcn_update_dpp(0, (int)mx, 0x141, 0xF, 0xF, false); mx = w > mx ? w : mx; }
#pragma unroll
                for (int i = 0; i < 16; ++i) key[i] = (key[i] == mx) ? 0u : key[i];
            }
#pragma unroll
            for (int i = 0; i < 16; ++i) selbits |= (key[i] == 0u && sub * 16 + i <= cur) ? (1u << i) : 0u;
        }
        selm[tok * 8 + sub] = (unsigned short)selbits;
    }
    __syncthreads();
    NSA_COMBINE(true, NSA_GT(0));
    {
        const bf16_t* Kb = P.kv + 2 * KVSZ + (size_t)bg * SEQ * 64; const bf16_t* Vb = P.kv + 3 * KVSZ + (size_t)bg * SEQ * 64;
        const unsigned* mwp = (const unsigned*)(selm + tl * 8); unsigned mwc = mwp[0];
        const int NT = cur + 1;
        constexpr int SLOTB = 8192, SV = 3 * SLOTB;
        const bf16_t* ksrc = Kb + ksoff; const bf16_t* vsrc = Vb + vsoff;
        const lds_cptr kq0 = kb0; const lds_cptr vq0 = vp0 + (SV - L_V);
#define SEL_DMA_K(t, slot) glds16(ksrc + (size_t)(t) * 4096, (unsigned)__builtin_amdgcn_readfirstlane(dma0 + (slot)))
#define SEL_DMA_V(t, slot) glds16(vsrc + (size_t)(t) * 4096, (unsigned)__builtin_amdgcn_readfirstlane(dma0 + SV + (slot)))
#define SEL_WAIT_BAR(N) asm volatile("s_waitcnt vmcnt(" #N ") lgkmcnt(0)\n\ts_barrier" ::: "memory")
#define SEL_SBAR() __builtin_amdgcn_sched_barrier(0)
#define SEL_PIN(x) asm volatile("" : "+v"(x))
#define SEL_EN(t) ((mwc >> ((t) & 31)) & 1u)
        float mhat = 0.f; bool resc = false; unsigned enp = ~0u;
        f32x16 lsum; bf16x8 onesf;
#pragma unroll
        for (int i = 0; i < 16; ++i) lsum[i] = 0.f;
#pragma unroll
        for (int i = 0; i < 8; ++i) onesf[i] = (short)0x3F80;
        f32x16 negm;
#pragma unroll
        for (int i = 0; i < 16; ++i) { o[0][i] = 0.f; o[1][i] = 0.f; }
        const f32x16 zero16 = {0.f, 0.f, 0.f, 0.f, 0.f, 0.f, 0.f, 0.f, 0.f, 0.f, 0.f, 0.f, 0.f, 0.f, 0.f, 0.f};
        f32x16 pA0, pA1, pB0, pB1; bf16x8 kf[8]; s16x4 vlo[8], vhi[8]; u32x4 pw0, pw1, pw2, pw3;
        int sl_prev = 0, sl_cur = 0, sl_next = SLOTB;
#define SEL_ROT() do { sl_prev = sl_cur; sl_cur = sl_next; sl_next = (sl_next == 2 * SLOTB) ? 0 : sl_next + SLOTB; } while (0)
#define SEL_KLD2(base, d0) do { kf[2 * (d0)] = *(const NLAS bf16x8*)((base) + (d0) * 2048); kf[2 * (d0) + 1] = *(const NLAS bf16x8*)((base) + (d0) * 2048 + 512); } while (0)
#define SEL_EX(v) __builtin_amdgcn_exp2f(fsub_s((v), mref))
#define SEL_RESC() do { if (resc) { _Pragma("unroll") for (int r = 0; r < 16; ++r) { const float f_ = wsf[crow(r, hi)]; o[0][r] *= f_; o[1][r] *= f_; lsum[r] *= f_; } } } while (0)
        SEL_WAIT_BAR(0);
#pragma unroll
        for (int d0 = 0; d0 < 4; ++d0) SEL_KLD2(kq0, d0);
        pA0 = MFMA32(kf[0], qr[0], zero16); pA1 = MFMA32(kf[1], qr[0], zero16); pA0 = MFMA32(kf[2], qr[1], pA0); pA1 = MFMA32(kf[3], qr[1], pA1);
        pA0 = MFMA32(kf[4], qr[2], pA0); pA1 = MFMA32(kf[5], qr[2], pA1); pA0 = MFMA32(kf[6], qr[3], pA0); pA1 = MFMA32(kf[7], qr[3], pA1);
        if (NT == 1) maskp(pA0, pA1, 0, tl, hi);
        { mfma_guard(pA0, pA1); const float rm0 = rowmax_a(pA0, pA1); mhat = rm0; const float mref = mhat;
#pragma unroll
          for (int r = 0; r < 16; ++r) { pA0[r] = SEL_EX(pA0[r]); pA1[r] = SEL_EX(pA1[r]); }
#pragma unroll
          for (int r = 0; r < 16; ++r) negm[r] = -mhat;
          SEL_PIN(negm); }
        SEL_WAIT_BAR(0);
        if (NT > 3) SEL_DMA_K(3, 0); if (NT > 1) SEL_DMA_V(1, SLOTB); SEL_ROT();
        if (NT > 1) {
#pragma unroll
            for (int d0 = 0; d0 < 4; ++d0) SEL_KLD2(kq0 + sl_cur, d0);
        }
        if (NT > 3) SEL_WAIT_BAR(2); else SEL_WAIT_BAR(0);
#define SEL_PKW(Pv, i) (cvtpk(Pv[i], Pv[(i) + 1]) & enp)
#define SEL_PAF(k) __builtin_bit_cast(bf16x8, pw##k)
#define SEL_VFR(i) __builtin_shufflevector(vlo[i], vhi[i], 0, 1, 2, 3, 4, 5, 6, 7)
#define SEL_VRD(i) do { vlo[i] = vtr(vp_ + (((i) >> 2) * 4096 + ((i) & 3) * 1024)); vhi[i] = vtr(vp_ + (((i) >> 2) * 4096 + ((i) & 3) * 1024 + 512)); } while (0)
#define SEL_KRD(G, d0) do { if (G) { SEL_KLD2(kq0 + sl_next, d0); SEL_SBAR(); } } while (0)
#define SEL_GAPA(MF, a0, a1, a2, a3, W0, W1, PW) do { MF; W0; W1; SEL_PIN(PW); SEL_SBAR(); } while (0)
#define SEL_GAPB(MF, X, i) do { MF; X[i] = __builtin_amdgcn_exp2f(X[i]); X[(i) + 1] = __builtin_amdgcn_exp2f(X[(i) + 1]); X[(i) + 2] = __builtin_amdgcn_exp2f(X[(i) + 2]); X[(i) + 3] = __builtin_amdgcn_exp2f(X[(i) + 3]); SEL_PIN(X); SEL_SBAR(); } while (0)
#define SEL_LSUM(k) do { lsum = MFMA32(SEL_PAF(k), onesf, lsum); SEL_SBAR(); } while (0)
#define SEL_STEP(C0, C1, P0, P1, t, MASK, GK, GV, GL) do { SEL_SBAR(); \
        const lds_cptr vp_ = vq0 + sl_prev; \
        SEL_VRD(0); SEL_SBAR(); \
                            SEL_GAPA(C0 = MFMA32(kf[0], qr[0], negm), P0[2], P0[3], P0[4], P0[5],     pw0[0] = SEL_PKW(P0, 0),  pw0[1] = SEL_PKW(P0, 2),  pw0); \
        SEL_VRD(4); SEL_SBAR(); SEL_GAPA(C1 = MFMA32(kf[1], qr[0], negm), P0[6], P0[7], P0[8], P0[9],     pw0[2] = SEL_PKW(P0, 4),  pw0[3] = SEL_PKW(P0, 6),  pw0); \
        SEL_VRD(1); SEL_SBAR(); SEL_GAPA(C0 = MFMA32(kf[2], qr[1], C0),    P0[10], P0[11], P0[12], P0[13], pw1[0] = SEL_PKW(P0, 8),  pw1[1] = SEL_PKW(P0, 10), pw1); \
        SEL_VRD(5); SEL_SBAR(); SEL_GAPA(C1 = MFMA32(kf[3], qr[1], C1),    P0[14], P0[15], P1[0], P1[1],   pw1[2] = SEL_PKW(P0, 12), pw1[3] = SEL_PKW(P0, 14), pw1); \
        SEL_VRD(2); SEL_SBAR(); SEL_GAPA(C0 = MFMA32(kf[4], qr[2], C0),    P1[2], P1[3], P1[4], P1[5],     pw2[0] = SEL_PKW(P1, 0),  pw2[1] = SEL_PKW(P1, 2),  pw2); \
        SEL_VRD(6); SEL_SBAR(); SEL_GAPA(C1 = MFMA32(kf[5], qr[2], C1),    P1[6], P1[7], P1[8], P1[9],     pw2[2] = SEL_PKW(P1, 4),  pw2[3] = SEL_PKW(P1, 6),  pw2); \
        SEL_VRD(3); SEL_SBAR(); SEL_GAPA(C0 = MFMA32(kf[6], qr[3], C0),    P1[10], P1[11], P1[12], P1[13], pw3[0] = SEL_PKW(P1, 8),  pw3[1] = SEL_PKW(P1, 10), pw3); \
        SEL_VRD(7); SEL_SBAR(); SEL_GAPA(C1 = MFMA32(kf[7], qr[3], C1),    P1[14], P1[15], 0.f, 0.f,       pw3[2] = SEL_PKW(P1, 12), pw3[3] = SEL_PKW(P1, 14), pw3); \
        if (GK) SEL_DMA_K((t) + 3, sl_cur); if (GV) SEL_DMA_V((t) + 1, sl_next); \
        if ((MASK) && (t) == NT - 1) maskp(C0, C1, 0, tl, hi); \
        if (((t) & 31) == 0) mwc = mwp[(t) >> 5]; \
        const bool en_ = SEL_EN(t) != 0u; \
        { mfma_guard(C0, C1); const float rmx = rowmax_a(C0, C1); const float rm = en_ ? rmx : -__builtin_inff(); resc = false; \
          if (__builtin_expect(__any(rm > THR), 0)) { const float dl = fmaxf(rm, 0.f); mhat += dl; \
              const float f = __builtin_amdgcn_exp2f(-dl); if (hi == 0) wsf[r32] = f; resc = true; \
              _Pragma("unroll") for (int r = 0; r < 16; ++r) { C0[r] -= dl; C1[r] -= dl; negm[r] = -mhat; } SEL_PIN(negm); } } \
        enp = en_ ? ~0u : 0u; SEL_SBAR(); \
        SEL_GAPB(o[0] = MFMA32(SEL_PAF(0), SEL_VFR(0), o[0]), C0, 0);                  SEL_GAPB(o[1] = MFMA32(SEL_PAF(0), SEL_VFR(4), o[1]), C0, 4); \
        SEL_KRD(GL, 0); SEL_GAPB(o[0] = MFMA32(SEL_PAF(1), SEL_VFR(1), o[0]), C0, 8);  SEL_KRD(GL, 1); SEL_GAPB(o[1] = MFMA32(SEL_PAF(1), SEL_VFR(5), o[1]), C0, 12); \
        SEL_KRD(GL, 2); SEL_GAPB(o[0] = MFMA32(SEL_PAF(2), SEL_VFR(2), o[0]), C1, 0);  SEL_KRD(GL, 3); SEL_GAPB(o[1] = MFMA32(SEL_PAF(2), SEL_VFR(6), o[1]), C1, 4); \
        SEL_GAPB(o[0] = MFMA32(SEL_PAF(3), SEL_VFR(3), o[0]), C1, 8);                  SEL_GAPB(o[1] = MFMA32(SEL_PAF(3), SEL_VFR(7), o[1]), C1, 12); \
        lsum = MFMA32(SEL_PAF(0), onesf, lsum); lsum = MFMA32(SEL_PAF(1), onesf, lsum); lsum = MFMA32(SEL_PAF(2), onesf, lsum); lsum = MFMA32(SEL_PAF(3), onesf, lsum); SEL_PIN(lsum); SEL_SBAR(); \
        } while (0)
#define SEL_ENDW(tt) do { if ((tt) + 3 < NT) { SEL_WAIT_BAR(2); } else if ((tt) + 2 < NT) { SEL_WAIT_BAR(1); } else { SEL_WAIT_BAR(0); } } while (0)
        int t = 1;
        for (; t + 5 < NT; t += 2) {
            SEL_STEP(pB0, pB1, pA0, pA1, t, false, true, true, true);     SEL_WAIT_BAR(2); SEL_RESC(); SEL_ROT();
            SEL_STEP(pA0, pA1, pB0, pB1, t + 1, false, true, true, true); SEL_WAIT_BAR(2); SEL_RESC(); SEL_ROT();
        }
        for (; t + 1 < NT; t += 2) {
            SEL_STEP(pB0, pB1, pA0, pA1, t, true, (t + 3 < NT), (t + 1 < NT), (t + 1 < NT));         SEL_ENDW(t);     SEL_RESC(); SEL_ROT();
            SEL_STEP(pA0, pA1, pB0, pB1, t + 1, true, (t + 4 < NT), (t + 2 < NT), (t + 2 < NT));     SEL_ENDW(t + 1); SEL_RESC(); SEL_ROT();
        }
        int vslot = sl_cur;
        if (t < NT) { SEL_STEP(pB0, pB1, pA0, pA1, t, true, false, false, false); SEL_RESC(); }
        else { pB0 = pA0; pB1 = pA1; vslot = sl_prev; }
        {
          pw0 = (u32x4){SEL_PKW(pB0, 0), SEL_PKW(pB0, 2), SEL_PKW(pB0, 4), SEL_PKW(pB0, 6)}; pw1 = (u32x4){SEL_PKW(pB0, 8), SEL_PKW(pB0, 10), SEL_PKW(pB0, 12), SEL_PKW(pB0, 14)};
          pw2 = (u32x4){SEL_PKW(pB1, 0), SEL_PKW(pB1, 2), SEL_PKW(pB1, 4), SEL_PKW(pB1, 6)}; pw3 = (u32x4){SEL_PKW(pB1, 8), SEL_PKW(pB1, 10), SEL_PKW(pB1, 12), SEL_PKW(pB1, 14)};
          const lds_cptr vp_ = vq0 + vslot;
#pragma unroll
          for (int i = 0; i < 8; ++i) SEL_VRD(i);
          o[0] = MFMA32(SEL_PAF(0), SEL_VFR(0), o[0]); o[1] = MFMA32(SEL_PAF(0), SEL_VFR(4), o[1]); o[0] = MFMA32(SEL_PAF(1), SEL_VFR(1), o[0]); o[1] = MFMA32(SEL_PAF(1), SEL_VFR(5), o[1]);
          o[0] = MFMA32(SEL_PAF(2), SEL_VFR(2), o[0]); o[1] = MFMA32(SEL_PAF(2), SEL_VFR(6), o[1]); o[0] = MFMA32(SEL_PAF(3), SEL_VFR(3), o[0]); o[1] = MFMA32(SEL_PAF(3), SEL_VFR(7), o[1]);
          lsum = MFMA32(SEL_PAF(0), onesf, lsum); lsum = MFMA32(SEL_PAF(1), onesf, lsum); lsum = MFMA32(SEL_PAF(2), onesf, lsum); lsum = MFMA32(SEL_PAF(3), onesf, lsum); }
        NSA_COMBINE_L(NSA_GT(1), lsum);
        __syncthreads();
#undef SEL_DMA_K
#undef SEL_DMA_V
#undef SEL_WAIT_BAR
#undef SEL_SBAR
#undef SEL_PIN
#undef SEL_EN
#undef SEL_ROT
#undef SEL_KLD2
#undef SEL_EX
#undef SEL_RESC
#undef SEL_PKW
#undef SEL_PAF
#undef SEL_VFR
#undef SEL_VRD
#undef SEL_KRD
#undef SEL_GAPA
#undef SEL_GAPB
#undef SEL_STEP
#undef SEL_LSUM
#undef SEL_ENDW
    }
    {
        const bf16_t* Kb = P.kv + 4 * KVSZ + (size_t)bg * SEQ * 64; const bf16_t* Vb = P.kv + 5 * KVSZ + (size_t)bg * SEQ * 64;
        float m = 0.f, l = 0.f;
#pragma unroll
        for (int i = 0; i < 16; ++i) { o[0][i] = 0.f; o[1][i] = 0.f; }
        const int j0 = (cur >= 8) ? cur - 8 : 0, NT = cur - j0 + 1, NI = (NT + 1) >> 1;
        if (NT > 1) NSA_DMA2(Kb, Vb, cur - 1, true, 0); else NSA_DMA2(Kb, Vb, cur, false, 0);
        NSA_DMAWAIT(); __syncthreads();
        for (int n = 0; n < NI; ++n) {
            const int slot = n & 1;
            if (n + 1 < NI) { const int ja1 = cur - 2 * n - 2; if (ja1 - 1 >= j0) NSA_DMA2(Kb, Vb, ja1 - 1, true, slot ^ 1); else NSA_DMA2(Kb, Vb, ja1, false, slot ^ 1); }
            {
                const int ja = cur - 2 * n, jb = ja - 1; const bool hasB = jb >= j0; const int offA = hasB ? 8192 : 0;
                bf16x8 kf[8], vf[8];
                kload(kf, kb0 + slot * 32768 + offA); vload(vf, vp0 + slot * 32768 + offA); __builtin_amdgcn_sched_barrier(0); qkt_f(p0, p1, kf, qr); __builtin_amdgcn_sched_barrier(0);
                if (hasB) kload(kf, kb0 + slot * 32768);
                { const int lo = (ja == cur - 8) ? tl + 1 : 0, hl = (ja == cur) ? tl : 63;
                  if (ja == cur - 8 || ja == cur) maskp(p0, p1, lo, hl, hi); }
                softmax_rel(p0, p1, m, l, o, wsf, r32, hi, true, n == 0);
                packp(pw, p0, p1);
                pvmul_f(o, vf, pw);
                if (hasB) {
                    vload(vf, vp0 + slot * 32768); __builtin_amdgcn_sched_barrier(0);
                    qkt_f(p0, p1, kf, qr);
                    if (jb == cur - 8) maskp(p0, p1, tl + 1, 63, hi);
                    softmax_rel(p0, p1, m, l, o, wsf, r32, hi, true, false);
                    packp(pw, p0, p1);
                    pvmul_f(o, vf, pw);
                }
            }
            NSA_DMAWAIT(); __syncthreads();
        }
        l = swapsum(l);
        NSA_COMBINE(false, NSA_GT(2) / l);
    }
    {
        const int row = lane >> 1, half = lane & 1;
        const float* src = ost + row * 64 + half * 32;
        bf16_t* dst = P.mix + ((size_t)b * SEQ + t0 + 8 * wid + (row >> 2)) * 1024 + g * 256 + (row & 3) * 64 + half * 32;
#pragma unroll
        for (int i = 0; i < 4; ++i) *(u32x4*)(dst + 8 * i) = pack8(*(const f32x4*)(src + 8 * i), *(const f32x4*)(src + 8 * i + 4));
    }
    __syncthreads();
#undef NSA_DMA2
#undef NSA_DMAWAIT
#undef NSA_COMBINE
#undef NSA_COMBINE_L
#undef NSA_GT
#undef ksoff
#undef vsoff
}
}

namespace ret {
using nsa::bf16x8; using nsa::s16x4; using nsa::f32x16; using nsa::lds_cptr; using nsa::vtr; using nsa::crow; using nsa::cvtpk;
__device__ __forceinline__ int timg(int j, int c) { return ((c >> 5) * 8 + (j >> 4)) * 1024 + (j & 15) * 64 + (c & 31) * 2; }
__device__ __forceinline__ bf16x8 trfrag(lds_cptr p) { const s16x4 lo = vtr(p), hi = vtr(p + 512); return __builtin_shufflevector(lo, hi, 0, 1, 2, 3, 4, 5, 6, 7); }
__device__ __forceinline__ void kv_unit(const bf16_t* kr, const bf16_t* vr, float* kvT, int unit, unsigned char* lds, NLAS unsigned char* lds3) {
    int tid_ = threadIdx.x; asm volatile("" : "+v"(tid_));
    const int tid = tid_, lane = tid & 63, wid = __builtin_amdgcn_readfirstlane(tid >> 6), r32 = lane & 31, hi = lane >> 5;
    const int h = (unit >> 6) & 3; const float l2g = __builtin_amdgcn_logf(1.f - __builtin_amdgcn_exp2f(-5.f - (float)h));
    const size_t base = (size_t)unit * 16384;
#pragma unroll
    for (int q = 0; q < 4; ++q) { const int c = tid + 512 * q, j = c >> 4, c8 = (c & 15) * 8;
        const u32x4 vv = *(const u32x4*)(vr + base + (size_t)c * 8), kk = *(const u32x4*)(kr + base + (size_t)c * 8);
        const float z = __builtin_amdgcn_exp2f((127.f - (float)j) * l2g);
        u32x4 kz; kz.x = cvtpk(bflo(kk.x) * z, bfhi(kk.x) * z); kz.y = cvtpk(bflo(kk.y) * z, bfhi(kk.y) * z); kz.z = cvtpk(bflo(kk.z) * z, bfhi(kk.z) * z); kz.w = cvtpk(bflo(kk.w) * z, bfhi(kk.w) * z);
        *(u32x4*)(lds + timg(j, c8)) = vv; *(u32x4*)(lds + 32768 + timg(j, c8)) = kz; }
    __syncthreads();
    const int eb = wid >> 1, dh = wid & 1;
    const lds_cptr lp = (lds_cptr)lds3 + ((lane >> 4) & 1) * 32 + (lane & 3) * 8 + (4 * hi + ((lane & 15) >> 2)) * 64;
    f32x16 acc[2];
#pragma unroll
    for (int i = 0; i < 16; ++i) { acc[0][i] = 0.f; acc[1][i] = 0.f; }
#pragma unroll
    for (int ks = 0; ks < 8; ++ks) {
        const bf16x8 af = trfrag(lp + (eb * 8 + ks) * 1024);
#pragma unroll
        for (int db = 0; db < 2; ++db) { const bf16x8 bfm = trfrag(lp + 32768 + ((2 * dh + db) * 8 + ks) * 1024); acc[db] = MFMA32(af, bfm, acc[db]); }
    }
#pragma unroll
    for (int db = 0; db < 2; ++db)
#pragma unroll
        for (int r = 0; r < 16; ++r) kvT[base + (size_t)(32 * eb + crow(r, hi)) * 128 + 64 * dh + 32 * db + r32] = acc[db][r];
    __syncthreads();
}
__device__ __forceinline__ void scan_phase(const float* kvT, bf16_t* spT) {
    int tid_ = threadIdx.x; asm volatile("" : "+v"(tid_));
    const int gtid = blockIdx.x * NTHREADS + tid_, gsz = gridDim.x * NTHREADS;
    for (int idx = gtid; idx < 16 * 8192; idx += gsz) {
        const int bh = idx >> 13, e2 = (idx & 8191) * 2; const float gc = __builtin_amdgcn_exp2f(128.f * __builtin_amdgcn_logf(1.f - __builtin_amdgcn_exp2f(-5.f - (float)(bh & 3))));
        const size_t off0 = ((size_t)(bh * 64) << 14) + e2;
        float2 kvv[63];
#pragma unroll
        for (int n = 0; n < 63; ++n) kvv[n] = *(const float2*)(kvT + off0 + ((size_t)n << 14));
        float s0 = 0.f, s1 = 0.f;
#pragma unroll
        for (int n = 0; n < 64; ++n) { *(unsigned*)(spT + off0 + ((size_t)n << 14)) = cvtpk(s0, s1);
            if (n < 63) { s0 = gc * s0 + kvv[n].x; s1 = gc * s1 + kvv[n].y; } }
    }
}
__device__ __forceinline__ void out_unit(const bf16_t* qr, const bf16_t* kr, const bf16_t* vr, const bf16_t* spT, const bf16_t* sg, const float* gng, const float* gnb, bf16_t* mix, int unit, unsigned char* lds, NLAS unsigned char* lds3) {
    int tid_ = threadIdx.x; asm volatile("" : "+v"(tid_));
    const int tid = tid_, lane = tid & 63, wid = __builtin_amdgcn_readfirstlane(tid >> 6), r32 = lane & 31, hi = lane >> 5;
    const int bh = unit >> 6, n = unit & 63, h = bh & 3, b = bh >> 2; const float l2g = __builtin_amdgcn_logf(1.f - __builtin_amdgcn_exp2f(-5.f - (float)h));
    const size_t base = (size_t)unit * 16384;
    constexpr int LQ = 0, LK = 32768, LV = 65536, LS = 98304;
#pragma unroll
    for (int q = 0; q < 4; ++q) { const int c = tid + 512 * q, j = c >> 4, ch = c & 15;
        *(u32x4*)(lds + LQ + ch * 2048 + j * 16) = *(const u32x4*)(qr + base + (size_t)c * 8);
        *(u32x4*)(lds + LK + ch * 2048 + j * 16) = *(const u32x4*)(kr + base + (size_t)c * 8);
        *(u32x4*)(lds + LV + timg(j, ch * 8)) = *(const u32x4*)(vr + base + (size_t)c * 8);
        *(u32x4*)(lds + LS + ch * 2048 + j * 16) = *(const u32x4*)(spT + base + (size_t)c * 8); }
    __syncthreads();
    const int rb = wid >> 1, eh = wid & 1;
    const lds_cptr l3 = (lds_cptr)lds3;
    const lds_cptr vlp = l3 + LV + ((lane >> 4) & 1) * 32 + (lane & 3) * 8 + (4 * hi + ((lane & 15) >> 2)) * 64;
    bf16x8 qf[8];
#pragma unroll
    for (int ks = 0; ks < 8; ++ks) qf[ks] = *(const NLAS bf16x8*)(l3 + LQ + (2 * ks + hi) * 2048 + (32 * rb + r32) * 16);
    f32x16 acc[2];
#pragma unroll
    for (int i = 0; i < 16; ++i) { acc[0][i] = 0.f; acc[1][i] = 0.f; }
#pragma unroll
    for (int ks = 0; ks < 8; ++ks)
#pragma unroll
        for (int eb = 0; eb < 2; ++eb) { const bf16x8 sf = *(const NLAS bf16x8*)(l3 + LS + (2 * ks + hi) * 2048 + (64 * eh + 32 * eb + r32) * 16); acc[eb] = MFMA32(qf[ks], sf, acc[eb]); }
#pragma unroll
    for (int r = 0; r < 16; ++r) { const float xi = __builtin_amdgcn_exp2f((float)(32 * rb + crow(r, hi) + 1) * l2g); acc[0][r] *= xi; acc[1][r] *= xi; }
    for (int jb = 0; jb <= rb; ++jb) {
        f32x16 p;
#pragma unroll
        for (int i = 0; i < 16; ++i) p[i] = 0.f;
#pragma unroll
        for (int ks = 0; ks < 8; ++ks) { const bf16x8 kf = *(const NLAS bf16x8*)(l3 + LK + (2 * ks + hi) * 2048 + (32 * jb + r32) * 16); p = MFMA32(kf, qf[ks], p); }
        const int irow = 32 * rb + r32;
#pragma unroll
        for (int r = 0; r < 16; ++r) { const int dl = irow - (32 * jb + crow(r, hi)); p[r] = (dl >= 0) ? p[r] * __builtin_amdgcn_exp2f((float)dl * l2g) : 0.f; }
        u32x4 pw[2];
        pw[0] = (u32x4){cvtpk(p[0], p[1]), cvtpk(p[2], p[3]), cvtpk(p[4], p[5]), cvtpk(p[6], p[7])};
        pw[1] = (u32x4){cvtpk(p[8], p[9]), cvtpk(p[10], p[11]), cvtpk(p[12], p[13]), cvtpk(p[14], p[15])};
#pragma unroll
        for (int eb = 0; eb < 2; ++eb)
#pragma unroll
            for (int k2 = 0; k2 < 2; ++k2) { const bf16x8 vf = trfrag(vlp + ((2 * eh + eb) * 8 + 2 * jb + k2) * 1024); acc[eb] = MFMA32(__builtin_bit_cast(bf16x8, pw[k2]), vf, acc[eb]); }
    }
    __syncthreads();
    float* ost = (float*)lds;
#pragma unroll
    for (int eb = 0; eb < 2; ++eb)
#pragma unroll
        for (int r = 0; r < 16; ++r) ost[(32 * rb + crow(r, hi)) * 128 + 64 * eh + 32 * eb + r32] = acc[eb][r];
    __syncthreads();
    {
        const int i = tid >> 2, q4 = tid & 3;
        f32x4 v[8];
#pragma unroll
        for (int k = 0; k < 8; ++k) v[k] = *(const f32x4*)(ost + i * 128 + 32 * q4 + 4 * k);
        float s1 = 0.f;
#pragma unroll
        for (int k = 0; k < 8; ++k) s1 += hsum4(v[k]);
        s1 += __shfl_xor(s1, 1); s1 += __shfl_xor(s1, 2);
        const float mu = s1 * (1.f / 128.f); float s2 = 0.f;
#pragma unroll
        for (int k = 0; k < 8; ++k) { v[k] = v[k] - mu; s2 += hsum4(v[k] * v[k]); }
        s2 += __shfl_xor(s2, 1); s2 += __shfl_xor(s2, 2);
        const float rstd = rsqrtf(s2 * (1.f / 128.f) + LN_EPS);
        const size_t token = (size_t)b * SEQ + n * 128 + i; const int e0 = h * 128 + 32 * q4;
#pragma unroll
        for (int k2 = 0; k2 < 4; ++k2) {
            const u32x4 gw = *(const u32x4*)(sg + token * 512 + e0 + 8 * k2);
            const f32x4 o0 = v[2 * k2] * rstd * *(const f32x4*)(gng + e0 + 8 * k2) + *(const f32x4*)(gnb + e0 + 8 * k2);
            const f32x4 o1 = v[2 * k2 + 1] * rstd * *(const f32x4*)(gng + e0 + 8 * k2 + 4) + *(const f32x4*)(gnb + e0 + 8 * k2 + 4);
            *(u32x4*)(mix + token * 1024 + 512 + e0 + 8 * k2) = pack8(o0 * (f32x4){bflo(gw.x), bfhi(gw.x), bflo(gw.y), bfhi(gw.y)}, o1 * (f32x4){bflo(gw.z), bfhi(gw.z), bflo(gw.w), bfhi(gw.w)});
        }
    }
    __syncthreads();
}
}

__device__ __forceinline__ void final_ln_phase(float* yf, const float* st, const float* lg, const float* lb) {
    int tid_ = threadIdx.x; asm volatile("" : "+v"(tid_));
    const int lane = tid_ & 63; const int gw = blockIdx.x * 8 + (tid_ >> 6), NGW = gridDim.x * 8;
    f32x4 g[4], bb[4];
#pragma unroll
    for (int j = 0; j < 4; ++j) { g[j] = *(const f32x4*)(lg + 256 * j + 4 * lane); bb[j] = *(const f32x4*)(lb + 256 * j + 4 * lane); }
    for (int row = gw; row < M; row += NGW) {
        float mu, rs; row_stats(st, row, mu, rs);
        f32x4* p = (f32x4*)(yf + (size_t)row * DM) + lane;
#pragma unroll
        for (int j = 0; j < 4; ++j) { const f32x4 v = p[64 * j]; p[64 * j] = (v - mu) * rs * g[j] + bb[j]; }
    }
}

#define XB_TMO      128
#define XB_XCNT(j)  (256  + 64 * (j))
#define XB_XSUB(j)  (1280 + 64 * (j))
#define XB_XGEN(j)  (2304 + 64 * (j))
#define XB_TOP      3328
#define XB_TOPGEN   3392
#define XCD_BAR_WORDS 3456
#define XB_SPIN_CAP (1u << 18)

__device__ __forceinline__ unsigned xb_ld(unsigned* p)              { return __hip_atomic_load(p, __ATOMIC_RELAXED, __HIP_MEMORY_SCOPE_AGENT); }
__device__ __forceinline__ unsigned xb_add(unsigned* p, unsigned v) { return __hip_atomic_fetch_add(p, v, __ATOMIC_RELAXED, __HIP_MEMORY_SCOPE_AGENT); }
__device__ __forceinline__ unsigned xb_xcc_id() { return (unsigned)__builtin_amdgcn_s_getreg((3 << 11) | 20) & 0xFu; }
#define XB_SPIN(cond, bar) do { unsigned _sp = 0; while (cond) { __builtin_amdgcn_s_sleep(1); \
    if ((++_sp & 255u) == 0u) { if (xb_ld(&(bar)[XB_TMO])) break; if (_sp > XB_SPIN_CAP) { atomicAdd(&(bar)[XB_TMO], 1u); break; } } } } while (0)

struct XcdBarrier {
    unsigned* bar; unsigned x;
    volatile PG8_LAS unsigned* st;
};

__device__ __forceinline__ XcdBarrier xcd_barrier_post(unsigned* bar, volatile PG8_LAS unsigned* st) {
    XcdBarrier b; b.bar = bar; b.x = xb_xcc_id(); b.st = st;
    if (threadIdx.x == 0) (void)xb_add(&bar[XB_XCNT(b.x)], 1u);
    return b;
}
__device__ __forceinline__ void xcd_barrier_complete(unsigned* bar, unsigned x, unsigned& nloc, unsigned& nx) {
    const unsigned G = gridDim.x * gridDim.y * gridDim.z;
    unsigned sum, cnt, mine, sp = 0u;
    for (;;) {
        sum = 0u; cnt = 0u; mine = 0u;
#pragma unroll
        for (unsigned j = 0; j < 16; ++j) { const unsigned c = xb_ld(&bar[XB_XCNT(j)]); sum += c; cnt += (c > 0u) ? 1u : 0u; mine = (j == x) ? c : mine; }
        if (sum == G) break;
        __builtin_amdgcn_s_sleep(1);
        if ((++sp & 255u) == 0u) { if (xb_ld(&bar[XB_TMO])) break; if (sp > XB_SPIN_CAP) { atomicAdd(&bar[XB_TMO], 1u); break; } }
    }
    nloc = mine > 0u ? mine : 1u; nx = cnt > 0u ? cnt : 1u;
}

__device__ __forceinline__ void xcd_barrier(const XcdBarrier& b) {
    asm volatile("s_waitcnt vmcnt(0)" ::: "memory");
    __syncthreads();
    if (threadIdx.x == 0) {
        unsigned* bar = b.bar;
        __builtin_amdgcn_s_waitcnt(0);
        unsigned nloc = b.st[0], nx = b.st[1];
        if (nloc == 0u) { xcd_barrier_complete(bar, b.x, nloc, nx); b.st[0] = nloc; b.st[1] = nx; }
        const unsigned old = xb_add(&bar[XB_XSUB(b.x)], 1u);
        const unsigned gen = old / nloc;
        if (old + 1u == (gen + 1u) * nloc) {
            __builtin_amdgcn_fence(__ATOMIC_RELEASE, "agent");
            asm volatile("s_waitcnt vmcnt(0)" ::: "memory");
            const unsigned og = xb_add(&bar[XB_TOP], 1u);
            const unsigned tg = og / nx;
            if (og + 1u == (tg + 1u) * nx) xb_add(&bar[XB_TOPGEN], 1u);
            else XB_SPIN(xb_ld(&bar[XB_TOPGEN]) == tg, bar);
            __builtin_amdgcn_fence(__ATOMIC_ACQUIRE, "agent");
            xb_add(&bar[XB_XGEN(b.x)], 1u);
            asm volatile("s_waitcnt vmcnt(0)" ::: "memory");
        } else {
            XB_SPIN(xb_ld(&bar[XB_XGEN(b.x)]) == gen, bar);
            __builtin_amdgcn_fence(__ATOMIC_ACQUIRE, "agent");
            asm volatile("s_waitcnt vmcnt(0)" ::: "memory");
        }
    }
    __syncthreads();
}

__device__ __forceinline__ void panel_rendezvous(unsigned* cnt, unsigned* bar) {
    asm volatile("s_waitcnt vmcnt(0)" ::: "memory");
    __syncthreads();
    if (threadIdx.x == 0) {
        __builtin_amdgcn_fence(__ATOMIC_RELEASE, "agent"); asm volatile("s_waitcnt vmcnt(0)" ::: "memory");
        (void)xb_add(cnt, 1u);
        XB_SPIN(xb_ld(cnt) < 4u, bar);
        __builtin_amdgcn_fence(__ATOMIC_ACQUIRE, "agent"); asm volatile("s_waitcnt vmcnt(0)" ::: "memory");
    }
    __syncthreads();
}
struct EpiGateLn {
    static constexpr bool PERM = true, AFTER_DRAIN = false;
    float* out; const bf16_t* xb; const bf16_t* pe; float* st_out; const float* st_in; const float* lg; const float* lb; const float* c1; const float* c2; const float* lg4; const float* lb4; float2* tab; unsigned* cnt; unsigned* bar;
    __device__ __forceinline__ void operator()(f32x4 (&acc)[2][2][4][2], const Unit& u, int wr, int wc, int fr, int fq) const {
        const int colw = wc * 32 + 8 * fq, nb = u.pn * 256 + colw;
        u32x4 xn[2], pn_[2];
#pragma unroll
        for (int bj = 0; bj < 2; ++bj) { const size_t off0 = (size_t)(u.pm * 256 + wr * 64 + fr) * DM + nb + bj * 128; xn[bj] = *(const u32x4*)(xb + off0); pn_[bj] = *(const u32x4*)(pe + off0); }
        panel_stats(st_in, u.pm, tab);
#pragma unroll
        for (int ai = 0; ai < 2; ++ai)
#pragma unroll
            for (int m = 0; m < 4; ++m) {
                const int row = u.pm * 256 + ai * 128 + wr * 64 + m * 16 + fr;
                u32x4 xw[2], pw[2];
#pragma unroll
                for (int bj = 0; bj < 2; ++bj) { xw[bj] = xn[bj]; pw[bj] = pn_[bj]; }
                if (ai * 4 + m < 7) { const int r2 = ai * 4 + m + 1; const int row2 = u.pm * 256 + (r2 >> 2) * 128 + wr * 64 + (r2 & 3) * 16 + fr;
#pragma unroll
                    for (int bj = 0; bj < 2; ++bj) { const size_t off2 = (size_t)row2 * DM + nb + bj * 128; xn[bj] = *(const u32x4*)(xb + off2); pn_[bj] = *(const u32x4*)(pe + off2); } }
                __builtin_amdgcn_sched_barrier(0);
                const float2 mr = tab[ai * 128 + wr * 64 + m * 16 + fr]; const float mu = mr.x, rs = mr.y;
                float s = 0.f, q = 0.f;
#pragma unroll
                for (int bj = 0; bj < 2; ++bj) {
                    const int col = nb + bj * 128;
#pragma unroll
                    for (int n = 0; n < 2; ++n) {
                        const f32x4 k1 = *(const f32x4*)(c1 + col + 4 * n), k2 = *(const f32x4*)(c2 + col + 4 * n), gv = *(const f32x4*)(lg + col + 4 * n), bv = *(const f32x4*)(lb + col + 4 * n);
                        const f32x4 gt = sigmoid4((acc[ai][bj][m][n] - k1 * mu) * rs + k2);
                        const unsigned pa = n ? pw[bj].z : pw[bj].x, pb = n ? pw[bj].w : pw[bj].y, xa = n ? xw[bj].z : xw[bj].x, xc = n ? xw[bj].w : xw[bj].y;
                        const f32x4 e = (f32x4){bflo(pa), bfhi(pa), bflo(pb), bfhi(pb)} * gt;
                        const f32x4 x = ((f32x4){bflo(xa), bfhi(xa), bflo(xc), bfhi(xc)} - mu) * rs * gv + bv;
                        const f32x4 y = x * ALPHA + e;
                        acc[ai][bj][m][n] = y;
                        s += hsum4(y); q += hsum4(y * y);
                    }
                }
                s = xsum32(xsum16(s)); q = xsum32(xsum16(q));
                if (fq == 0) *(float2*)(st_out + (size_t)row * 32 + (u.pn * 4 + wc) * 2) = make_float2(s, q);
            }
        panel_rendezvous(cnt + 16 * u.pm, bar);
        panel_stats(st_out, u.pm, tab);
#pragma unroll
        for (int ai = 0; ai < 2; ++ai)
#pragma unroll
            for (int m = 0; m < 4; ++m) {
                const int row = u.pm * 256 + ai * 128 + wr * 64 + m * 16 + fr;
                const float2 mr = tab[ai * 128 + wr * 64 + m * 16 + fr];
#pragma unroll
                for (int bj = 0; bj < 2; ++bj) {
                    const int col = nb + bj * 128; const size_t off = (size_t)row * DM + col;
#pragma unroll
                    for (int n = 0; n < 2; ++n) *(f32x4*)(out + off + 4 * n) = (acc[ai][bj][m][n] - mr.x) * mr.y * *(const f32x4*)(lg4 + col + 4 * n) + *(const f32x4*)(lb4 + col + 4 * n);
                }
            }
    }
};

#ifndef PH_MASK
#define PH_MASK 0xFFFF
#endif
#define PH(k) ((PH_MASK >> (k)) & 1)
__global__ void __launch_bounds__(NTHREADS, 2) fwd_mega(Args a) {
    extern __shared__ __attribute__((aligned(16))) unsigned char lds[];
    PG8_LAS unsigned char* ldsp = (PG8_LAS unsigned char*)lds;
    const int G = gridDim.x, bid = blockIdx.x;
    unsigned char* ws = a.ws;
    bf16_t* wb = (bf16_t*)(ws + OFF_W);
    float* vec = (float*)(ws + OFF_VEC);
    float* st1 = (float*)(ws + OFF_STATS); float* st2 = st1 + (size_t)M * 32; float* st3 = st2 + (size_t)M * 32; float* st4 = st3 + (size_t)M * 32;
    bf16_t* yb = (bf16_t*)(ws + OFF_YB); bf16_t* pb = (bf16_t*)(ws + OFF_PB); bf16_t* pe = (bf16_t*)(ws + OFF_PE); bf16_t* hb = (bf16_t*)(ws + OFF_HB);
    bf16_t* qn = hb + HB_QN; bf16_t* kvb = hb + HB_KV; bf16_t* qr = hb + HB_QR; bf16_t* kr = hb + HB_KR; bf16_t* vr = hb + HB_VR;
    bf16_t* sg = (bf16_t*)(ws + OFF_SG); float* gates = (float*)(ws + OFF_GATES); float* kvst = (float*)(ws + OFF_KVST); bf16_t* mix = (bf16_t*)(ws + OFF_KVST);
    bf16_t* sprev = (bf16_t*)a.out;
    bf16_t* ch = (bf16_t*)(ws + OFF_CH); bf16_t* kcmp = (bf16_t*)(ws + OFF_KCMP);
    const float* lng = a.in[13]; const float* lnb = a.in[14];
    float* yf = a.out;
    float2* ptab = (float2*)(lds + 131072);
    volatile PG8_LAS unsigned* misc = (volatile PG8_LAS unsigned*)(ldsp + 140000);
    if (threadIdx.x < 4) misc[threadIdx.x] = 0u;
    __syncthreads();
    XcdBarrier xbar = xcd_barrier_post((unsigned*)ws, misc);
#define GRID_BAR() xcd_barrier(xbar)

    if (PH(0)) prep_phase(a, lds);
    GRID_BAR();
    if (PH(1)) reduce_vec_phase(a);
    if (PH(1)) { pg8::Gemm g{yb, wb + W_13A, M, 5632, 1024, 1024}; pg8::StaticOrder S; S.init(M, 5632, G, bid);
      EpiSwigluT<false> E{hb, nullptr, nullptr, nullptr, ptab};
      pg8::gemm_phase<EpiSwigluT<false>, pg8::StaticOrder, true, true>(ldsp, g, S, E); }
    GRID_BAR();
    if (PH(2)) { pg8::Gemm g{hb, wb + W_2A, M, 1024, DFF, HP}; pg8::StaticOrder S; S.init(M, 1024, G, bid);
      EpiRes<false> E{yb, yb, st1, nullptr, nullptr, nullptr, 0.5f, ptab};
      pg8::gemm_phase<EpiRes<false>, pg8::StaticOrder, true, true>(ldsp, g, S, E); }
    GRID_BAR();
    if (PH(3)) { pg8::Gemm g{yb, wb + W_IN, M, NINP, 1024, 1024}; pg8::StaticOrder S; S.init(M, NINP, G, bid);
      EpiInProj E{st1, vec + V_C1, vec + V_C2, qn, kvb, qr, kr, vr, sg, gates, ptab};
      pg8::gemm_phase<EpiInProj, pg8::StaticOrder, true, true>(ldsp, g, S, E); }
    GRID_BAR();
    if (PH(4)) { const int j = bid >> 4;
      pg8::Gemm g{kvb + (size_t)(j & 1) * KVSZ, wb + ((j & 1) ? W_C1V : W_C1K), 4096, 256, 2048, 1024}; OneUnit S{bid & 15, bid < 32};
      EpiCmp1 E{ch + (size_t)(j & 1) * 4096 * 256, vec + V_CB + (j & 1) * 256};
      pg8::gemm_phase<EpiCmp1, OneUnit, false, true>(ldsp, g, S, E); }
    __syncthreads();
    { const bool side = (G > 64) ? (bid >= 32) : true; const int Gs = (G > 64) ? G - 32 : G, cs = (G > 64) ? bid - 32 : bid;
      if (side) {
          for (int u = cs; u < 1024; u += Gs) ret::kv_unit(kr, vr, kvst, u, lds, ldsp);
          int kple = PLE; asm volatile("" : "+s"(kple)); pg8::Gemm g{pb, wb + W_PLE, M, 1024, kple, kple}; pg8::StaticOrder S; S.init(M, 1024, Gs, cs);
          EpiPlain E{pe};
          pg8::gemm_phase<EpiPlain, pg8::StaticOrder, true, true>(ldsp, g, S, E);
      } }
    GRID_BAR();
    if (PH(6)) { const int j = bid >> 4;
      int kc2 = 256; asm volatile("" : "+s"(kc2)); pg8::Gemm g{ch + (size_t)(j & 1) * 4096 * 256, wb + ((j & 1) ? W_C2V : W_C2K), 4096, 256, kc2, kc2}; OneUnit S{bid & 15, bid < 32};
      EpiCmp2 E{kcmp + (size_t)(j & 1) * KCMP_J};
      pg8::gemm_phase<EpiCmp2, OneUnit, false, true>(ldsp, g, S, E); }
    if (PH(7)) ret::scan_phase(kvst, sprev);
    GRID_BAR();
    if (PH(8)) { const nsa::Ptrs NP{qn, kvb, kcmp, gates, mix};
      if (G == 256) { const int bgx = bid & 7, pr = bid >> 3;
#pragma nounroll
          for (int k = 0; k < 4; ++k) { const int itile = (k == 0) ? 127 - pr : (k == 1) ? 95 - pr : (k == 2) ? pr + 32 : pr; nsa::unit(NP, bgx, itile, lds, ldsp); } }
      else for (int u = bid; u < 1024; u += G) nsa::unit(NP, u & 7, u >> 3, lds, ldsp); }
    if (PH(9)) for (int u = bid; u < 1024; u += G) ret::out_unit(qr, kr, vr, sprev, sg, a.in[8], a.in[9], mix, u, lds, ldsp);
    GRID_BAR();
    if (PH(10)) { pg8::Gemm g{mix, wb + W_OUT, M, 1024, 1024, 1024}; pg8::StaticOrder S; S.init(M, 1024, G, bid);
      EpiRes<true> E{yb, yb, st2, st1, lng, lnb, 1.0f, ptab};
      pg8::gemm_phase<EpiRes<true>, pg8::StaticOrder, true, true>(ldsp, g, S, E); }
    GRID_BAR();
    if (PH(11)) { pg8::Gemm g{yb, wb + W_13B, M, 5632, 1024, 1024}; pg8::StaticOrder S; S.init(M, 5632, G, bid);
      EpiSwigluT<true> E{hb, st2, vec + V_C1 + NINP, vec + V_C2 + NINP, ptab};
      pg8::gemm_phase<EpiSwigluT<true>, pg8::StaticOrder, true, true>(ldsp, g, S, E); }
    GRID_BAR();
    if (PH(12)) { pg8::Gemm g{hb, wb + W_2B, M, 1024, DFF, HP}; pg8::StaticOrder S; S.init(M, 1024, G, bid);
      EpiRes<true> E{yb, yb, st3, st2, lng + 1024, lnb + 1024, 0.5f, ptab};
      pg8::gemm_phase<EpiRes<true>, pg8::StaticOrder, true, true>(ldsp, g, S, E); }
    GRID_BAR();
    if (G == 256) {
        pg8::Gemm g{yb, wb + W_PG, M, 1024, 1024, 1024}; pg8::StaticOrder S; S.init(M, 1024, G, bid);
        EpiGateLn E{yf, yb, pe, st4, st3, lng + 2048, lnb + 2048, vec + V_C1 + NINP + 5632, vec + V_C2 + NINP + 5632, lng + 3072, lnb + 3072, ptab, (unsigned*)(ws + 16384), (unsigned*)ws};
        pg8::gemm_phase<EpiGateLn, pg8::StaticOrder, true, true>(ldsp, g, S, E);
    } else {
        { pg8::Gemm g{yb, wb + W_PG, M, 1024, 1024, 1024}; pg8::StaticOrder S; S.init(M, 1024, G, bid);
          EpiGate E{yf, yb, pe, st4, st3, lng + 2048, lnb + 2048, vec + V_C1 + NINP + 5632, vec + V_C2 + NINP + 5632, ptab};
          pg8::gemm_phase<EpiGate, pg8::StaticOrder, true, true>(ldsp, g, S, E); }
        GRID_BAR();
        final_ln_phase(yf, st4, lng + 3072, lnb + 3072);
    }
}

extern "C" void kernel_launch(void* const* d_in, const int* in_sizes, int n_in, void* d_out, int out_size, void* d_ws, size_t ws_size, hipStream_t stream) {
    static int grid_blocks = 0;
    if (!grid_blocks) {
        int dev = 0, cus = 0, per_cu = 0;
        (void)hipGetDevice(&dev);
        (void)hipDeviceGetAttribute(&cus, hipDeviceAttributeMultiprocessorCount, dev);
        (void)hipFuncSetAttribute((const void*)fwd_mega, hipFuncAttributeMaxDynamicSharedMemorySize, LDS_BYTES);
        (void)hipOccupancyMaxActiveBlocksPerMultiprocessor(&per_cu, (const void*)fwd_mega, NTHREADS, LDS_BYTES);
        if (per_cu < 1) fprintf(stderr, "kernel_launch: occupancy query reports %d blocks per CU\n", per_cu);
        if (ws_size < WS_NEED || n_in != 15 || out_size != M * DM) fprintf(stderr, "kernel_launch: unexpected sizes: ws %zu (need %zu), n_in %d, out %d\n", ws_size, (size_t)WS_NEED, n_in, out_size);
        grid_blocks = cus;
    }
    (void)hipMemsetAsync(d_ws, 0, 32768, stream);
    Args a{};
    for (int i = 0; i < 15; ++i) a.in[i] = (const float*)d_in[i];
    a.out = (float*)d_out; a.ws = (unsigned char*)d_ws;
    void* args[] = {&a};
    const hipError_t e = hipLaunchCooperativeKernel((const void*)fwd_mega, dim3(grid_blocks), dim3(NTHREADS), args, LDS_BYTES, stream);
    if (e != hipSuccess) fprintf(stderr, "kernel_launch: cooperative launch failed: %s (grid %d)\n", hipGetErrorString(e), grid_blocks);
}
```

```cpp
#include <hip/hip_runtime.h>
#include <cstdio>
#include <cstdint>
namespace pg8 {
#define PG8_LAS __attribute__((address_space(3)))
typedef unsigned short bf16_t;
typedef short bf16x8 __attribute__((ext_vector_type(8)));
typedef float f32x4 __attribute__((ext_vector_type(4)));
typedef unsigned u32x4 __attribute__((ext_vector_type(4)));
constexpr int BM = 256, BK = 64, HALF = 128, HTB = HALF * BK * 2  , STAGE_BYTES = 8 * HTB, NXCD = 8, WGM = 8;

__host__ __device__ __forceinline__ int lds_byte(int r, int c) { const int st = (r >> 4) * 2 + (c >> 5), rr = r & 15, cc = c & 31, ob = rr * 64 + cc * 2; return st * 1024 + (ob ^ (((ob >> 9) & 1) << 5)); }
__host__ __device__ __forceinline__ void stage_rc(int b, int& R, int& C) { const int st = b / 1024, sb = b % 1024, swz = sb ^ (((sb >> 9) & 1) << 5); R = (st >> 1) * 16 + swz / 64; C = (st & 1) * 32 + (swz % 64) / 2; }
__host__ __device__ __forceinline__ int perm32(int rho) { const int n = rho >> 4, i = rho & 15; return 8 * (i >> 2) + 4 * n + (i & 3); }

struct Unit { int pm, pn; };
struct Gemm { const bf16_t* A; const bf16_t* Bt; int M, N, K, lda; };

struct StaticOrder {
    int nM, nN, nwg, G, c;
    __host__ __device__ void init(int M, int N, int G_, int c_) { nM = M / BM; nN = N / BM; nwg = nM * nN; G = G_; c = c_; }
    __host__ __device__ bool next(int i, Unit& u) const {
        const long L = (long)i * G + c; if (L >= nwg) return false;
        int wgid = (int)L; { const int q = nwg / NXCD, r = nwg % NXCD, xcd = wgid % NXCD, off = wgid / NXCD; wgid = (xcd < r ? xcd * (q + 1) : r * (q + 1) + (xcd - r) * q) + off; }
        const int nig = WGM * nN, gid = wgid / nig, fm = gid * WGM, gsz = (nM - fm) < WGM ? (nM - fm) : WGM;
        u.pm = fm + ((wgid % nig) % gsz); u.pn = (wgid % nig) / gsz; return true;
    }
    __device__ __forceinline__ void a_ready(const Unit&) const {}
    __device__ __forceinline__ void done(const Unit&) const {}
};

typedef float f32x2_cv __attribute__((ext_vector_type(2))); typedef __bf16 bf16x2_cv __attribute__((ext_vector_type(2)));
__device__ __forceinline__ unsigned cvt_pk_bf16(float lo, float hi) { f32x2_cv v = {lo, hi}; bf16x2_cv b = __builtin_convertvector(v, bf16x2_cv); return __builtin_bit_cast(unsigned, b); }
template <class Epi, class Sched, bool ALIGN_EPI = false, bool SP2 = false>
__device__ __forceinline__ void gemm_phase(PG8_LAS unsigned char* lds, const Gemm g, const Sched& S, const Epi& E) {
    int tid_ = threadIdx.x; asm volatile("" : "+v"(tid_));
    const int tid = tid_, wid = __builtin_amdgcn_readfirstlane(tid >> 6), lane = tid & 63, wr = wid >> 2, wc = wid & 3, fr = lane & 15, fq = lane >> 4;
    const int K = g.K, nt = K / BK;
    unsigned voffA[2], voffB[2];
#pragma unroll
    for (int i = 0; i < 2; ++i) { int R, C; stage_rc(tid * 16 + i * 8192, R, C); const int Rb = Epi::PERM ? ((R & ~31) + perm32(R & 31)) : R;
        voffA[i] = (unsigned)(R * g.lda + C) * 2u; voffB[i] = (unsigned)(Rb * K + C) * 2u; }
    const size_t kstep = (size_t)(BK * 2);
    const size_t hstepA = (size_t)HALF * g.lda * 2, hstepB = (size_t)HALF * K * 2;
    const size_t tstepA = 2 * hstepA, tstepB = 2 * hstepB;
    const unsigned ldsw = (unsigned)wid * 1024u;
    const int aoff = lds_byte(wr * 64 + fr, fq * 8), boff = lds_byte(wc * 32 + fr, fq * 8);
#define PG8_SA(b, h) (((b) * 2 + (h)) * HTB)
#define PG8_SB(b, h) ((4 + (b) * 2 + (h)) * HTB)
#define PG8_STAGE(bufoff, gbase, voff) do { _Pragma("unroll") for (int _i = 0; _i < 2; ++_i) \
        __builtin_amdgcn_global_load_lds((const unsigned*)((const char*)(gbase) + (voff)[_i]), (PG8_LAS unsigned*)(lds + (bufoff) + ldsw + _i * 8192), 16, 0, 0); } while (0)
#define PG8_LDA(dst, b, h) do { _Pragma("unroll") for (int m = 0; m < 4; ++m) _Pragma("unroll") for (int k = 0; k < 2; ++k) dst[m][k] = *(const PG8_LAS bf16x8*)(lds + PG8_SA(b, h) + aoff + m * 2048 + k * 1024); } while (0)
#define PG8_LDB(dst, b, h) do { _Pragma("unroll") for (int n = 0; n < 2; ++n) _Pragma("unroll") for (int k = 0; k < 2; ++k) dst[n][k] = *(const PG8_LAS bf16x8*)(lds + PG8_SB(b, h) + boff + n * 2048 + k * 1024); } while (0)
#define PG8_MMA(ai, bj, At, Bt) do { __builtin_amdgcn_s_setprio(1); _Pragma("unroll") for (int m = 0; m < 4; ++m) _Pragma("unroll") for (int n = 0; n < 2; ++n) _Pragma("unroll") for (int k = 0; k < 2; ++k) \
        acc[ai][bj][m][n] = __builtin_amdgcn_mfma_f32_16x16x32_bf16(Bt[n][k], At[m][k], acc[ai][bj][m][n], 0, 0, 0); __builtin_amdgcn_s_setprio(0); } while (0)
#define PG8_WAIT_V(n) asm volatile("s_waitcnt vmcnt(" #n ")" ::: "memory")
#define PG8_WAIT_L(n) asm volatile("s_waitcnt lgkmcnt(" #n ")" ::: "memory")
#define PG8_BAR __builtin_amdgcn_s_barrier()
#define PG8_SCHED __builtin_amdgcn_sched_barrier(0)
    Unit cur, nxt; int ui = 0;
    if (!S.next(0, cur)) return;
    f32x4 acc[2][2][4][2];
#pragma unroll
    for (int a = 0; a < 2; ++a)
#pragma unroll
        for (int b = 0; b < 2; ++b)
#pragma unroll
            for (int m = 0; m < 4; ++m)
#pragma unroll
                for (int n = 0; n < 2; ++n) acc[a][b][m][n] = (f32x4){0.f, 0.f, 0.f, 0.f};
    bf16x8 At[4][2], B0[2][2], B1[2][2];
    const char* cA = (const char*)g.A + (size_t)cur.pm * tstepA; const char* cB = (const char*)g.Bt + (size_t)cur.pn * tstepB;
    S.a_ready(cur);
    if constexpr (SP2) {
        PG8_STAGE(PG8_SB(0, 0), cB, voffB); PG8_STAGE(PG8_SB(0, 1), cB + hstepB, voffB); PG8_STAGE(PG8_SA(0, 0), cA, voffA); PG8_STAGE(PG8_SA(0, 1), cA + hstepA, voffA);
        if (wr == 1) PG8_BAR;
        PG8_WAIT_V(2); PG8_BAR;
        PG8_STAGE(PG8_SB(1, 0), cB + kstep, voffB); PG8_STAGE(PG8_SA(1, 0), cA + kstep, voffA); PG8_STAGE(PG8_SB(1, 1), cB + hstepB + kstep, voffB);
        PG8_WAIT_V(6); PG8_BAR;
    } else {
        PG8_STAGE(PG8_SB(0, 0), cB, voffB); PG8_STAGE(PG8_SA(0, 0), cA, voffA); PG8_STAGE(PG8_SB(0, 1), cB + hstepB, voffB); PG8_STAGE(PG8_SA(0, 1), cA + hstepA, voffA);
        if (wr == 1) PG8_BAR;
        PG8_WAIT_V(4); PG8_BAR;
        PG8_STAGE(PG8_SB(1, 0), cB + kstep, voffB); PG8_STAGE(PG8_SA(1, 0), cA + kstep, voffA); PG8_STAGE(PG8_SB(1, 1), cB + hstepB + kstep, voffB);
        PG8_WAIT_V(6); PG8_BAR;
    }
    for (;;) {
        const bool has_next = S.next(ui + 1, nxt);
        const char* nA = has_next ? (const char*)g.A + (size_t)nxt.pm * tstepA : cA; const char* nB = has_next ? (const char*)g.Bt + (size_t)nxt.pn * tstepB : cB;
        for (int t = 0; t < nt; t += 2) {
            const bool last = (t == nt - 2);
            const char* a1 = cA + (size_t)(t + 1) * kstep;
            const char* a2 = last ? nA : cA + (size_t)(t + 2) * kstep; const char* b2 = last ? nB : cB + (size_t)(t + 2) * kstep;
            const char* a3 = a2 + kstep; const char* b3 = b2 + kstep;
            if (last && has_next) S.a_ready(nxt);
            if constexpr (SP2) {
            PG8_LDB(B0, 0, 0); PG8_LDB(B1, 0, 1); PG8_SCHED; PG8_LDA(At, 0, 0); PG8_STAGE(PG8_SA(1, 1), a1 + hstepA, voffA);
            PG8_WAIT_V(8); PG8_WAIT_L(0); PG8_BAR; PG8_MMA(0, 0, At, B0); PG8_MMA(0, 1, At, B1); PG8_BAR; PG8_SCHED;
            PG8_LDA(At, 0, 1); PG8_STAGE(PG8_SB(0, 0), b2, voffB); PG8_STAGE(PG8_SB(0, 1), b2 + hstepB, voffB); PG8_STAGE(PG8_SA(0, 0), a2, voffA);
            PG8_WAIT_V(8); PG8_WAIT_L(0); PG8_BAR; PG8_MMA(1, 0, At, B0); PG8_MMA(1, 1, At, B1); PG8_BAR; PG8_SCHED;
            PG8_LDB(B0, 1, 0); PG8_LDB(B1, 1, 1); PG8_SCHED; PG8_LDA(At, 1, 0); PG8_STAGE(PG8_SA(0, 1), a2 + hstepA, voffA);
            PG8_WAIT_V(8); PG8_WAIT_L(0); PG8_BAR; PG8_MMA(0, 0, At, B0); PG8_MMA(0, 1, At, B1); PG8_BAR; PG8_SCHED;
            PG8_LDA(At, 1, 1); PG8_STAGE(PG8_SB(1, 0), b3, voffB); PG8_STAGE(PG8_SB(1, 1), b3 + hstepB, voffB); PG8_STAGE(PG8_SA(1, 0), a3, voffA);
            PG8_WAIT_V(8); PG8_WAIT_L(0); PG8_BAR; PG8_MMA(1, 0, At, B0); PG8_MMA(1, 1, At, B1); PG8_BAR; PG8_SCHED;
            } else {
            PG8_LDB(B0, 0, 0); PG8_SCHED; PG8_LDA(At, 0, 0); PG8_STAGE(PG8_SA(1, 1), a1 + hstepA, voffA);
            PG8_WAIT_L(8); PG8_BAR; PG8_WAIT_L(0); PG8_MMA(0, 0, At, B0); PG8_BAR; PG8_SCHED;
            PG8_LDB(B1, 0, 1); PG8_STAGE(PG8_SB(0, 0), b2, voffB);
            PG8_BAR; PG8_WAIT_L(0); PG8_MMA(0, 1, At, B1); PG8_BAR;
            PG8_LDA(At, 0, 1); PG8_STAGE(PG8_SA(0, 0), a2, voffA);
            PG8_BAR; PG8_WAIT_L(0); PG8_MMA(1, 0, At, B0); PG8_BAR; PG8_SCHED;
            PG8_STAGE(PG8_SB(0, 1), b2 + hstepB, voffB);
            PG8_WAIT_V(6); PG8_BAR; PG8_MMA(1, 1, At, B1); PG8_BAR;
            PG8_LDB(B0, 1, 0); PG8_SCHED; PG8_LDA(At, 1, 0); PG8_STAGE(PG8_SA(0, 1), a2 + hstepA, voffA);
            PG8_WAIT_L(8); PG8_BAR; PG8_WAIT_L(0); PG8_MMA(0, 0, At, B0); PG8_BAR; PG8_SCHED;
            PG8_LDB(B1, 1, 1); PG8_STAGE(PG8_SB(1, 0), b3, voffB);
            PG8_BAR; PG8_WAIT_L(0); PG8_MMA(0, 1, At, B1); PG8_BAR;
            PG8_LDA(At, 1, 1); PG8_STAGE(PG8_SA(1, 0), a3, voffA);
            PG8_BAR; PG8_WAIT_L(0); PG8_MMA(1, 0, At, B0); PG8_BAR; PG8_SCHED;
            PG8_STAGE(PG8_SB(1, 1), b3 + hstepB, voffB);
            PG8_WAIT_V(6); PG8_BAR; PG8_MMA(1, 1, At, B1); PG8_BAR;
            }
        }
        if constexpr (ALIGN_EPI) { if (wr == 0) PG8_BAR; }
        if constexpr (!Epi::AFTER_DRAIN) { E(acc, cur, wr, wc, fr, fq); S.done(cur); }
        if (!has_next) break;
#pragma unroll
        for (int a = 0; a < 2; ++a)
#pragma unroll
            for (int b = 0; b < 2; ++b)
#pragma unroll
                for (int m = 0; m < 4; ++m)
#pragma unroll
                    for (int n = 0; n < 2; ++n) acc[a][b][m][n] = (f32x4){0.f, 0.f, 0.f, 0.f};
        cur = nxt; cA = nA; cB = nB; ++ui;
        if constexpr (ALIGN_EPI) { if (wr == 1) PG8_BAR; }
    }
    PG8_WAIT_V(0);
    if constexpr (!ALIGN_EPI) { if (wr == 0) PG8_BAR; }
    PG8_BAR;
    if constexpr (Epi::AFTER_DRAIN) { E.fused(acc, cur, wr, wc, fr, fq, lds, wid, lane); S.done(cur); }
#undef PG8_SA
#undef PG8_SB
#undef PG8_STAGE
#undef PG8_LDA
#undef PG8_LDB
#undef PG8_MMA
#undef PG8_WAIT_V
#undef PG8_WAIT_L
#undef PG8_BAR
#undef PG8_SCHED
}
}

using pg8::bf16_t; using pg8::f32x4; using pg8::u32x4; using pg8::Unit;
typedef unsigned u32x2 __attribute__((ext_vector_type(2)));
constexpr int NTHREADS = 512;
constexpr int LDS_BYTES = 147456;
constexpr int SEQ = 8192, DM = 1024, M = 4 * SEQ;
constexpr int DFF = 2816, NIN = 3352, NINP = 3584, PLE = 256;
constexpr int HP = 2944;
constexpr float ALPHA = 1.189207115002721f;
constexpr float LN_EPS = 1e-5f;
constexpr size_t MiB = 1u << 20;
constexpr size_t OFF_VEC = 1 * MiB;
constexpr size_t OFF_ROT = 4 * MiB;
constexpr size_t OFF_STATS = 8 * MiB;
constexpr size_t OFF_W = 24 * MiB;
constexpr size_t OFF_YB = 72 * MiB;
constexpr size_t OFF_PB = 136 * MiB;
constexpr size_t OFF_PE = 152 * MiB;
constexpr size_t OFF_HB = 216 * MiB;
constexpr size_t OFF_SG = 400 * MiB;
constexpr size_t OFF_GATES = 432 * MiB;
constexpr size_t OFF_KVST = 436 * MiB;
constexpr size_t OFF_CH = 500 * MiB;
constexpr size_t OFF_KCMP = 504 * MiB;
constexpr size_t WS_NEED = 505 * MiB;
constexpr size_t W_13A = 0, W_13B = W_13A + (size_t)5632 * 1024, W_2A = W_13B + (size_t)5632 * 1024, W_2B = W_2A + (size_t)1024 * 2816,
                 W_IN = W_2B + (size_t)1024 * 2816, W_C1K = W_IN + (size_t)NINP * 1024, W_C1V = W_C1K + 256 * 2048, W_C2K = W_C1V + 256 * 2048,
                 W_C2V = W_C2K + 256 * 256, W_OUT = W_C2V + 256 * 256, W_PLE = W_OUT + 1024 * 1024, W_PG = W_PLE + 1024 * 256, W_END = W_PG + 1024 * 1024;
static_assert(W_END * 2 <= 48 * MiB, "weights region");
constexpr int NCV = NINP + 5632 + 1024;
constexpr int V_C1 = 0, V_C2 = V_C1 + NCV, V_CB = V_C2 + NCV, V_CPART = V_CB + 512, V_CBP = V_CPART + 16 * NCV * 2, V_END = V_CBP + 32 * 512;
static_assert((size_t)V_END * 4 <= 3 * MiB, "vec region");
constexpr size_t HB_QN = 0, HB_KV = HB_QN + (size_t)M * 512, KVSZ = (size_t)8 * SEQ * 64, HB_QR = HB_KV + 6 * KVSZ, HB_KR = HB_QR + (size_t)M * 512, HB_VR = HB_KR + (size_t)M * 512;
static_assert((HB_VR + (size_t)M * 512) * 2 <= 176 * MiB, "HB overlay");
constexpr size_t KCMP_J = (size_t)4096 * 64;

struct Args { const float* in[15]; float* out; unsigned char* ws; };

__device__ __forceinline__ float bf2f(unsigned h) { return __uint_as_float(h << 16); }
__device__ __forceinline__ float bflo(unsigned w) { return __uint_as_float(w << 16); }
__device__ __forceinline__ float bfhi(unsigned w) { return __uint_as_float(w & 0xffff0000u); }
__device__ __forceinline__ unsigned f2bf(float f) { unsigned u = __float_as_uint(f); return (u + 0x7fffu + ((u >> 16) & 1u)) >> 16; }
__device__ __forceinline__ float bfround(float f) { return __uint_as_float(f2bf(f) << 16); }
__device__ __forceinline__ u32x4 pack8(f32x4 a, f32x4 b) { u32x4 w; w.x = pg8::cvt_pk_bf16(a[0], a[1]); w.y = pg8::cvt_pk_bf16(a[2], a[3]); w.z = pg8::cvt_pk_bf16(b[0], b[1]); w.w = pg8::cvt_pk_bf16(b[2], b[3]); return w; }
__device__ __forceinline__ float sigmoid_f(float v) { return __builtin_amdgcn_rcpf(1.f + __builtin_amdgcn_exp2f(-1.4426950408889634f * v)); }
__device__ __forceinline__ float silu_f(float v) { return v * __builtin_amdgcn_rcpf(1.f + __builtin_amdgcn_exp2f(-1.4426950408889634f * v)); }
__device__ __forceinline__ float gelu_tanh_f(float v) { const float u = 0.7978845608028654f * (v + 0.044715f * v * v * v); return v * __builtin_amdgcn_rcpf(1.f + __builtin_amdgcn_exp2f(-2.8853900817779268f * u)); }
__device__ __forceinline__ f32x4 silu4(f32x4 v) { return (f32x4){silu_f(v[0]), silu_f(v[1]), silu_f(v[2]), silu_f(v[3])}; }
__device__ __forceinline__ f32x4 sigmoid4(f32x4 v) { return (f32x4){sigmoid_f(v[0]), sigmoid_f(v[1]), sigmoid_f(v[2]), sigmoid_f(v[3])}; }
__device__ __forceinline__ float hsum4(f32x4 v) { return (v[0] + v[1]) + (v[2] + v[3]); }
__device__ __forceinline__ float xsum16(float a) { auto rr = __builtin_amdgcn_permlane16_swap(__float_as_uint(a), __float_as_uint(a), false, false); return __uint_as_float(rr[0]) + __uint_as_float(rr[1]); }
__device__ __forceinline__ float xsum32(float a) { auto rr = __builtin_amdgcn_permlane32_swap(__float_as_uint(a), __float_as_uint(a), false, false); return __uint_as_float(rr[0]) + __uint_as_float(rr[1]); }
__device__ __forceinline__ float wave_max(float v) {
#pragma unroll
    for (int o = 1; o < 64; o <<= 1) v = fmaxf(v, __shfl_xor(v, o));
    return v; }
__device__ __forceinline__ float wave_sum(float v) {
#pragma unroll
    for (int o = 1; o < 64; o <<= 1) v += __shfl_xor(v, o);
    return v; }
__device__ __forceinline__ int wave_min_i(int v) {
#pragma unroll
    for (int o = 1; o < 64; o <<= 1) { const int w = __shfl_xor(v, o); v = w < v ? w : v; }
    return v; }
__device__ __forceinline__ void row_stats(const float* st, int row, float& mu, float& rs) {
    const f32x4* p = (const f32x4*)(st + (size_t)row * 32);
    float s = 0.f, q = 0.f;
#pragma unroll
    for (int i = 0; i < 8; ++i) { const f32x4 v = p[i]; s += v[0] + v[2]; q += v[1] + v[3]; }
    mu = s * (1.f / 1024.f); const float var = fmaxf(q * (1.f / 1024.f) - mu * mu, 0.f); rs = rsqrtf(var + LN_EPS);
}

__device__ __forceinline__ void panel_stats(const float* st, int pm, float2* tab) {
    int t_ = threadIdx.x; asm volatile("" : "+v"(t_)); const int t = t_, row = t >> 1, half = t & 1;
    const f32x4* p = (const f32x4*)(st + (size_t)(pm * 256 + row) * 32 + half * 16);
    float s = 0.f, q = 0.f;
#pragma unroll
    for (int i = 0; i < 4; ++i) { const f32x4 v = p[i]; s += v[0] + v[2]; q += v[1] + v[3]; }
    s += __shfl_xor(s, 1); q += __shfl_xor(q, 1);
    const float mu = s * (1.f / 1024.f), var = fmaxf(q * (1.f / 1024.f) - mu * mu, 0.f);
    if (half == 0) tab[row] = make_float2(mu, rsqrtf(var + LN_EPS));
    asm volatile("s_waitcnt lgkmcnt(0)" ::: "memory"); __builtin_amdgcn_s_barrier(); asm volatile("" ::: "memory");
}

template <bool LN> struct EpiRes {
    static constexpr bool PERM = true, AFTER_DRAIN = false;
    const bf16_t* xb; bf16_t* yb; float* st_out; const float* st_in; const float* lg; const float* lb; float coef; float2* tab;
    __device__ __forceinline__ void operator()(const f32x4 (&acc)[2][2][4][2], const Unit& u, int wr, int wc, int fr, int fq) const {
        const int colw = wc * 32 + 8 * fq;
        constexpr int NB = LN ? 2 : 1, RB = 8 / NB;
        f32x4 gv[2][2], bv[2][2];
#pragma unroll
        for (int bj = 0; bj < 2; ++bj)
#pragma unroll
            for (int n = 0; n < 2; ++n) { const int col = u.pn * 256 + bj * 128 + colw + 4 * n;
                gv[bj][n] = LN ? *(const f32x4*)(lg + col) : (f32x4){1.f, 1.f, 1.f, 1.f}; bv[bj][n] = LN ? *(const f32x4*)(lb + col) : (f32x4){0.f, 0.f, 0.f, 0.f}; }
        u32x4 xw[RB][2];
#define ER_LOAD(bt) do { _Pragma("unroll") for (int k = 0; k < RB; ++k) { const int rr_ = (bt) * RB + k, ai_ = rr_ >> 2, m_ = rr_ & 3; \
            _Pragma("unroll") for (int bj = 0; bj < 2; ++bj) xw[k][bj] = *(const u32x4*)(xb + (size_t)(u.pm * 256 + ai_ * 128 + wr * 64 + m_ * 16 + fr) * DM + u.pn * 256 + bj * 128 + colw); } } while (0)
        ER_LOAD(0);
        if (LN) panel_stats(st_in, u.pm, tab);
#pragma unroll
        for (int bt = 0; bt < NB; ++bt) {
            if (bt > 0) ER_LOAD(bt);
            __builtin_amdgcn_sched_barrier(0);
#pragma unroll
            for (int k = 0; k < RB; ++k) { const int rr = bt * RB + k, ai = rr >> 2, m = rr & 3;
                const int row = u.pm * 256 + ai * 128 + wr * 64 + m * 16 + fr;
                float mu = 0.f, rs = 1.f; if (LN) { const float2 mr = tab[ai * 128 + wr * 64 + m * 16 + fr]; mu = mr.x; rs = mr.y; }
                float s = 0.f, q = 0.f;
#pragma unroll
                for (int bj = 0; bj < 2; ++bj) {
                    const u32x4 w = xw[k][bj];
                    f32x4 x0 = (f32x4){bflo(w.x), bfhi(w.x), bflo(w.y), bfhi(w.y)}, x1 = (f32x4){bflo(w.z), bfhi(w.z), bflo(w.w), bfhi(w.w)};
                    if (LN) { x0 = (x0 - mu) * rs * gv[bj][0] + bv[bj][0]; x1 = (x1 - mu) * rs * gv[bj][1] + bv[bj][1]; }
                    const size_t off = (size_t)row * DM + u.pn * 256 + bj * 128 + colw;
                    const f32x4 y0 = x0 * ALPHA + acc[ai][bj][m][0] * coef, y1 = x1 * ALPHA + acc[ai][bj][m][1] * coef;
                    const u32x4 yw = pack8(y0, y1);
                    *(u32x4*)(yb + off) = yw;
                    s += hsum4(y0) + hsum4(y1); q += hsum4(y0 * y0) + hsum4(y1 * y1);
                }
                s = xsum32(xsum16(s)); q = xsum32(xsum16(q));
                if (fq == 0) *(float2*)(st_out + (size_t)row * 32 + (u.pn * 4 + wc) * 2) = make_float2(s, q);
            }
        }
#undef ER_LOAD
    }
};

template <bool FOLD> struct EpiSwigluT {
    static constexpr bool PERM = true, AFTER_DRAIN = false;
    bf16_t* O; const float* st_in; const float* c1; const float* c2; float2* tab;
    mutable int last_pm = -1;
    __device__ __forceinline__ void operator()(const f32x4 (&acc)[2][2][4][2], const Unit& u, int wr, int wc, int fr, int fq) const {
        const int colw = wc * 32 + 8 * fq, nb = u.pn * 256 + colw;
        if (FOLD && u.pm != last_pm) { panel_stats(st_in, u.pm, tab); last_pm = u.pm; }
        f32x4 k1[2][2], k2[2][2];
#pragma unroll
        for (int bj = 0; bj < 2; ++bj)
#pragma unroll
            for (int n = 0; n < 2; ++n) { k1[bj][n] = FOLD ? *(const f32x4*)(c1 + nb + bj * 128 + 4 * n) : (f32x4){0.f, 0.f, 0.f, 0.f}; k2[bj][n] = FOLD ? *(const f32x4*)(c2 + nb + bj * 128 + 4 * n) : (f32x4){0.f, 0.f, 0.f, 0.f}; }
#pragma unroll
        for (int ai = 0; ai < 2; ++ai)
#pragma unroll
            for (int m = 0; m < 4; ++m) {
                const int row = u.pm * 256 + ai * 128 + wr * 64 + m * 16 + fr;
                float mu = 0.f, rs = 1.f; if (FOLD) { const float2 mr = tab[ai * 128 + wr * 64 + m * 16 + fr]; mu = mr.x; rs = mr.y; }
                f32x4 h[2];
#pragma unroll
                for (int n = 0; n < 2; ++n) {
                    const f32x4 a = FOLD ? (acc[ai][0][m][n] - k1[0][n] * mu) * rs + k2[0][n] : acc[ai][0][m][n], g = FOLD ? (acc[ai][1][m][n] - k1[1][n] * mu) * rs + k2[1][n] : acc[ai][1][m][n];
                    h[n] = silu4(a) * g; }
                *(u32x4*)(O + (size_t)row * HP + u.pn * 128 + colw) = pack8(h[0], h[1]);
            }
    }
};

struct EpiInProj {
    static constexpr bool PERM = true, AFTER_DRAIN = false;
    const float* st_in; const float* c1; const float* c2;
    bf16_t* qn; bf16_t* kv; bf16_t* qr; bf16_t* kr; bf16_t* vr; bf16_t* sg; float* gates; float2* tab;
    mutable int last_pm = -1;
    __device__ __forceinline__ void operator()(const f32x4 (&acc)[2][2][4][2], const Unit& u, int wr, int wc, int fr, int fq) const {
        const int pn = u.pn, colw = wc * 32 + 8 * fq, nb = pn * 256 + colw;
        if (u.pm != last_pm) { panel_stats(st_in, u.pm, tab); last_pm = u.pm; }
        f32x4 k1[2][2], k2[2][2];
#pragma unroll
        for (int bj = 0; bj < 2; ++bj)
#pragma unroll
            for (int n = 0; n < 2; ++n) { k1[bj][n] = *(const f32x4*)(c1 + nb + bj * 128 + 4 * n); k2[bj][n] = *(const f32x4*)(c2 + nb + bj * 128 + 4 * n); }
        float frv[8];
#pragma unroll
        for (int i = 0; i < 8; ++i) frv[i] = (pn >= 5 && pn < 9) ? __builtin_amdgcn_exp2f(-(float)(2 * ((colw & 63) + i)) * (13.287712379549449f / 128.f)) * 0.15915494309189535f : 0.f;
#pragma unroll
        for (int ai = 0; ai < 2; ++ai)
#pragma unroll
            for (int m = 0; m < 4; ++m) {
                const int row = u.pm * 256 + ai * 128 + wr * 64 + m * 16 + fr; const int b = row >> 13, t = row & 8191;
                const float2 mr = tab[ai * 128 + wr * 64 + m * 16 + fr]; const float mu = mr.x, rs = mr.y;
                f32x4 v[2][2];
#pragma unroll
                for (int bj = 0; bj < 2; ++bj)
#pragma unroll
                    for (int n = 0; n < 2; ++n) v[bj][n] = (acc[ai][bj][m][n] - k1[bj][n] * mu) * rs + k2[bj][n];
                if (pn < 2) {
#pragma unroll
                    for (int bj = 0; bj < 2; ++bj) *(u32x4*)(qn + (size_t)row * 512 + pn * 256 + bj * 128 + colw) = pack8(v[bj][0] * 0.18033688011112042f, v[bj][1] * 0.18033688011112042f);
                } else if (pn < 5) {
#pragma unroll
                    for (int bj = 0; bj < 2; ++bj) { const int kc = (pn - 2) * 256 + bj * 128 + colw; const int j = kc >> 7, g = (kc >> 6) & 1, d = kc & 63;
                        *(u32x4*)(kv + (size_t)j * KVSZ + ((size_t)((b * 2 + g) * SEQ + t)) * 64 + d) = pack8(v[bj][0], v[bj][1]); }
                } else if (pn < 9) {
                    const bool isk = pn >= 7; const int hp = isk ? pn - 7 : pn - 5; const int hh = colw >> 6, jj = colw & 63, head = 2 * hp + hh;
                    f32x4 cs0, cs1, sn0, sn1; const float tf = (float)t;
#pragma unroll
                    for (int i = 0; i < 4; ++i) { const float r0 = __builtin_amdgcn_fractf(tf * frv[i]), r1 = __builtin_amdgcn_fractf(tf * frv[4 + i]);
                        cs0[i] = __builtin_amdgcn_cosf(r0); sn0[i] = __builtin_amdgcn_sinf(r0); cs1[i] = __builtin_amdgcn_cosf(r1); sn1[i] = __builtin_amdgcn_sinf(r1); }
                    const float sc = isk ? 0.08838834764831845f : 1.f;
                    const f32x4 a0 = (v[0][0] * cs0 - v[1][0] * sn0) * sc, a1 = (v[0][1] * cs1 - v[1][1] * sn1) * sc;
                    const f32x4 b0 = (v[0][0] * sn0 + v[1][0] * cs0) * sc, b1 = (v[0][1] * sn1 + v[1][1] * cs1) * sc;
                    bf16_t* dst = (isk ? kr : qr) + ((size_t)((b * 4 + head) * SEQ + t)) * 128 + jj;
                    *(u32x4*)dst = pack8(a0, a1); *(u32x4*)(dst + 64) = pack8(b0, b1);
                } else if (pn < 11) {
#pragma unroll
                    for (int bj = 0; bj < 2; ++bj) { const int col = (pn - 9) * 256 + bj * 128 + colw; const int head = col >> 7, e = col & 127;
                        *(u32x4*)(vr + ((size_t)((b * 4 + head) * SEQ + t)) * 128 + e) = pack8(v[bj][0], v[bj][1]); }
                } else if (pn < 13) {
#pragma unroll
                    for (int bj = 0; bj < 2; ++bj) *(u32x4*)(sg + (size_t)row * 512 + (pn - 11) * 256 + bj * 128 + colw) = pack8(silu4(v[bj][0]), silu4(v[bj][1]));
                } else {
                    if (wc == 0 && fq < 3) { *(f32x4*)(gates + (size_t)row * 24 + 8 * fq) = sigmoid4(v[0][0]); *(f32x4*)(gates + (size_t)row * 24 + 8 * fq + 4) = sigmoid4(v[0][1]); }
                }
            }
    }
};

struct EpiCmp1 {
    static constexpr bool PERM = true, AFTER_DRAIN = false;
    bf16_t* O; const float* bias;
    __device__ __forceinline__ void operator()(const f32x4 (&acc)[2][2][4][2], const Unit& u, int wr, int wc, int fr, int fq) const {
        const int colw = wc * 32 + 8 * fq;
#pragma unroll
        for (int ai = 0; ai < 2; ++ai)
#pragma unroll
            for (int m = 0; m < 4; ++m) {
                const int row = u.pm * 256 + ai * 128 + wr * 64 + m * 16 + fr;
#pragma unroll
                for (int bj = 0; bj < 2; ++bj) { const int col = bj * 128 + colw;
                    f32x4 a = acc[ai][bj][m][0] + *(const f32x4*)(bias + col), c = acc[ai][bj][m][1] + *(const f32x4*)(bias + col + 4);
                    a = (f32x4){gelu_tanh_f(a[0]), gelu_tanh_f(a[1]), gelu_tanh_f(a[2]), gelu_tanh_f(a[3])}; c = (f32x4){gelu_tanh_f(c[0]), gelu_tanh_f(c[1]), gelu_tanh_f(c[2]), gelu_tanh_f(c[3])};
                    *(u32x4*)(O + (size_t)row * 256 + col) = pack8(a, c); }
            }
    }
};
struct EpiCmp2 {
    static constexpr bool PERM = true, AFTER_DRAIN = false;
    bf16_t* O;
    __device__ __forceinline__ void operator()(const f32x4 (&acc)[2][2][4][2], const Unit& u, int wr, int wc, int fr, int fq) const {
        if (wc >= 2) return;
        const int colw = wc * 32 + 8 * fq;
#pragma unroll
        for (int ai = 0; ai < 2; ++ai)
#pragma unroll
            for (int m = 0; m < 4; ++m) { const int row = u.pm * 256 + ai * 128 + wr * 64 + m * 16 + fr;
                *(u32x4*)(O + (size_t)row * 64 + colw) = pack8(acc[ai][0][m][0], acc[ai][0][m][1]); }
    }
};
struct EpiPlain {
    static constexpr bool PERM = true, AFTER_DRAIN = false; static constexpr int ldc = 1024;
    bf16_t* O;
    __device__ __forceinline__ void operator()(const f32x4 (&acc)[2][2][4][2], const Unit& u, int wr, int wc, int fr, int fq) const {
        const int colw = wc * 32 + 8 * fq;
#pragma unroll
        for (int ai = 0; ai < 2; ++ai)
#pragma unroll
            for (int m = 0; m < 4; ++m) { const int row = u.pm * 256 + ai * 128 + wr * 64 + m * 16 + fr;
#pragma unroll
                for (int bj = 0; bj < 2; ++bj) *(u32x4*)(O + (size_t)row * ldc + u.pn * 256 + bj * 128 + colw) = pack8(acc[ai][bj][m][0], acc[ai][bj][m][1]);
                asm volatile("" ::: "memory"); }
    }
};
struct EpiGate {
    static constexpr bool PERM = true, AFTER_DRAIN = false;
    float* yf; const bf16_t* xb; const bf16_t* pe; float* st_out; const float* st_in; const float* lg; const float* lb; const float* c1; const float* c2; float2* tab;
    __device__ __forceinline__ void operator()(const f32x4 (&acc)[2][2][4][2], const Unit& u, int wr, int wc, int fr, int fq) const {
        const int colw = wc * 32 + 8 * fq, nb = u.pn * 256 + colw;
        panel_stats(st_in, u.pm, tab);
#pragma unroll
        for (int ai = 0; ai < 2; ++ai)
#pragma unroll
            for (int m = 0; m < 4; ++m) {
                const int row = u.pm * 256 + ai * 128 + wr * 64 + m * 16 + fr;
                u32x4 xw[2], pw[2];
#pragma unroll
                for (int bj = 0; bj < 2; ++bj) { const size_t off = (size_t)row * DM + nb + bj * 128; xw[bj] = *(const u32x4*)(xb + off); pw[bj] = *(const u32x4*)(pe + off); }
                const float2 mr = tab[ai * 128 + wr * 64 + m * 16 + fr]; const float mu = mr.x, rs = mr.y;
                float s = 0.f, q = 0.f;
#pragma unroll
                for (int bj = 0; bj < 2; ++bj) {
                    const int col = nb + bj * 128; const size_t off = (size_t)row * DM + col;
#pragma unroll
                    for (int n = 0; n < 2; ++n) {
                        const f32x4 k1 = *(const f32x4*)(c1 + col + 4 * n), k2 = *(const f32x4*)(c2 + col + 4 * n), gv = *(const f32x4*)(lg + col + 4 * n), bv = *(const f32x4*)(lb + col + 4 * n);
                        const f32x4 gt = sigmoid4((acc[ai][bj][m][n] - k1 * mu) * rs + k2);
                        const unsigned pa = n ? pw[bj].z : pw[bj].x, pb = n ? pw[bj].w : pw[bj].y, xa = n ? xw[bj].z : xw[bj].x, xc = n ? xw[bj].w : xw[bj].y;
                        const f32x4 e = (f32x4){bflo(pa), bfhi(pa), bflo(pb), bfhi(pb)} * gt;
                        const f32x4 x = ((f32x4){bflo(xa), bfhi(xa), bflo(xc), bfhi(xc)} - mu) * rs * gv + bv;
                        const f32x4 y = x * ALPHA + e;
                        *(f32x4*)(yf + off + 4 * n) = y;
                        s += hsum4(y); q += hsum4(y * y);
                    }
                }
                s = xsum32(xsum16(s)); q = xsum32(xsum16(q));
                if (fq == 0) *(float2*)(st_out + (size_t)row * 32 + (u.pn * 4 + wc) * 2) = make_float2(s, q);
            }
    }
};
struct OneUnit {
    int pm; bool on;
    __device__ __forceinline__ bool next(int i, Unit& u) const { if (i != 0 || !on) return false; u.pm = pm; u.pn = 0; return true; }
    __device__ __forceinline__ void a_ready(const Unit&) const {}
    __device__ __forceinline__ void done(const Unit&) const {}
};

struct MatDesc { const float* W; bf16_t* Bt; const float* gk; const float* bk; int K, N, Np, map, mode, cbase; };
__device__ __forceinline__ int map_col(int map, int n) {
    if (map == 0) { const int tile = n >> 8, w = n & 255; return (w >> 7) * DFF + tile * 128 + (w & 127); }
    if (map == 1) return n;
    if (map == 2) {
        const int pn = n >> 8, w = n & 255;
        if (pn < 5) return n;
        if (pn < 9) { const int base = (pn < 7) ? 1304 : 1816; const int hp = (pn < 7) ? pn - 5 : pn - 7; const int bj = w >> 7, hh = (w >> 6) & 1, jj = w & 63; return base + (2 * hp + hh) * 128 + 64 * bj + jj; }
        if (pn < 11) return 2328 + (n - 9 * 256);
        if (pn < 13) return 2840 + (n - 11 * 256);
        return (w < 24) ? 1280 + w : -1;
    }
    return (n < 64) ? n : -1;
}
__device__ __forceinline__ MatDesc get_mat(const Args& a, int id) {
    bf16_t* wb = (bf16_t*)(a.ws + OFF_W); const float* lng = a.in[13];
    MatDesc d;
    const float* lnb = a.in[14];
    switch (id) {
    case 0: d = MatDesc{a.in[2], wb + W_13A, nullptr, nullptr, 1024, 5632, 5632, 0, 0, 0}; break;
    case 1: d = MatDesc{a.in[2] + (size_t)1024 * 5632, wb + W_13B, lng + 1024, lnb + 1024, 1024, 5632, 5632, 0, 1, NINP}; break;
    case 2: d = MatDesc{a.in[3], wb + W_2A, nullptr, nullptr, 2816, 1024, 1024, 1, 0, 0}; break;
    case 3: d = MatDesc{a.in[3] + (size_t)2816 * 1024, wb + W_2B, nullptr, nullptr, 2816, 1024, 1024, 1, 0, 0}; break;
    case 4: d = MatDesc{a.in[4], wb + W_IN, lng, lnb, 1024, NIN, NINP, 2, 1, 0}; break;
    case 5: d = MatDesc{a.in[6], wb + W_C1K, nullptr, a.in[5], 2048, 256, 256, 1, 2, 0}; break;
    case 6: d = MatDesc{a.in[6] + 2048 * 256, wb + W_C1V, nullptr, a.in[5] + 2048, 2048, 256, 256, 1, 2, 256}; break;
    case 7: d = MatDesc{a.in[7], wb + W_C2K, nullptr, nullptr, 256, 64, 256, 3, 0, 0}; break;
    case 8: d = MatDesc{a.in[7] + 256 * 64, wb + W_C2V, nullptr, nullptr, 256, 64, 256, 3, 0, 0}; break;
    case 9: d = MatDesc{a.in[10], wb + W_OUT, nullptr, nullptr, 1024, 1024, 1024, 1, 0, 0}; break;
    case 10: d = MatDesc{a.in[11], wb + W_PLE, nullptr, nullptr, 256, 1024, 1024, 1, 0, 0}; break;
    default: d = MatDesc{a.in[12], wb + W_PG, lng + 2048, lnb + 2048, 1024, 1024, 1024, 1, 1, NINP + 5632}; break;
    }
    return d;
}
__device__ __forceinline__ void titem_load(const MatDesc& d, int item, int lane, f32x4 (&wv)[8]) {
    const int nblk = d.Np / 32, kb = item / nblk, nb = item % nblk, k0 = 64 * kb, n0 = 32 * nb;
    const int c4 = (lane & 7) * 4, kr = lane >> 3;
    const int sc = map_col(d.map, n0 + c4);
#pragma unroll
    for (int i = 0; i < 8; ++i) { const int kk = 8 * i + kr; wv[i] = (sc >= 0) ? *(const f32x4*)(d.W + (size_t)(k0 + kk) * d.N + sc) : (f32x4){0.f, 0.f, 0.f, 0.f}; }
}
__device__ __forceinline__ void titem_finish(const MatDesc& d, float* scr, float* vec, int item, int lane, const f32x4 (&wv)[8]) {
    const int nblk = d.Np / 32, kb = item / nblk, nb = item % nblk, k0 = 64 * kb, n0 = 32 * nb;
    const int c4 = (lane & 7) * 4, kr = lane >> 3;
    f32x4 s1 = {0.f, 0.f, 0.f, 0.f}, s2 = {0.f, 0.f, 0.f, 0.f};
#pragma unroll
    for (int i = 0; i < 8; ++i) { const int kk = 8 * i + kr;
        f32x4 w = wv[i];
        if (d.mode == 1) { const f32x4 wg = w * d.gk[k0 + kk]; s1 += (f32x4){bfround(wg[0]), bfround(wg[1]), bfround(wg[2]), bfround(wg[3])}; s2 += w * d.bk[k0 + kk]; w = wg; }
        else if (d.mode == 2) s1 += w * d.bk[k0 + kk];
        float* sp = scr + kk * 33 + c4; sp[0] = w[0]; sp[1] = w[1]; sp[2] = w[2]; sp[3] = w[3]; }
    if (d.mode != 0) {
#pragma unroll
        for (int e = 0; e < 4; ++e) { s1[e] += __shfl_xor(s1[e], 8); s1[e] += __shfl_xor(s1[e], 16); s1[e] += __shfl_xor(s1[e], 32); s2[e] += __shfl_xor(s2[e], 8); s2[e] += __shfl_xor(s2[e], 16); s2[e] += __shfl_xor(s2[e], 32); }
        if (lane < 8) {
            if (d.mode == 1) { float* cp = vec + V_CPART + ((size_t)kb * NCV + d.cbase + n0 + c4) * 2;
#pragma unroll
                for (int e = 0; e < 4; ++e) { cp[2 * e] = s1[e]; cp[2 * e + 1] = s2[e]; } }
            else *(f32x4*)(vec + V_CBP + kb * 512 + d.cbase + n0 + c4) = s1; } }
    __builtin_amdgcn_fence(__ATOMIC_RELEASE, "workgroup"); __builtin_amdgcn_wave_barrier(); __builtin_amdgcn_fence(__ATOMIC_ACQUIRE, "workgroup");
    const int c = lane & 7;
#pragma unroll
    for (int j = 0; j < 4; ++j) { const int n = (lane >> 3) + 8 * j; const float* s = scr + (8 * c) * 33 + n;
        u32x4 o; o.x = pg8::cvt_pk_bf16(s[0 * 33], s[1 * 33]); o.y = pg8::cvt_pk_bf16(s[2 * 33], s[3 * 33]); o.z = pg8::cvt_pk_bf16(s[4 * 33], s[5 * 33]); o.w = pg8::cvt_pk_bf16(s[6 * 33], s[7 * 33]);
        *(u32x4*)(d.Bt + (size_t)(n0 + n) * d.K + k0 + 8 * c) = o; }
    __builtin_amdgcn_fence(__ATOMIC_RELEASE, "workgroup"); __builtin_amdgcn_wave_barrier(); __builtin_amdgcn_fence(__ATOMIC_ACQUIRE, "workgroup");
}
__device__ __forceinline__ void prep_weights(const Args& a, unsigned char* lds, const bool late, const int gw, const int NGW) {
    int tid_ = threadIdx.x; asm volatile("" : "+v"(tid_));
    const int lane = tid_ & 63, wave = tid_ >> 6;
    float* scr = (float*)(lds + wave * 16384);
    {
        const int cnt[12] = {late ? 0 : 2816, late ? 2816 : 0, late ? 0 : 1408, late ? 0 : 1408, late ? 0 : 1792, late ? 0 : 256, late ? 0 : 256, late ? 0 : 32, late ? 0 : 32, late ? 0 : 512, late ? 0 : 128, late ? 512 : 0};
        int total = 0;
#pragma unroll
        for (int i = 0; i < 12; ++i) total += cnt[i];
        int it = gw, rc = 0, idc = 0; f32x4 wa[8];
        if (it < total) { rc = it;
#pragma unroll
            for (int i = 0; i < 11; ++i) { if (idc == i && rc >= cnt[i]) { rc -= cnt[i]; idc = i + 1; } }
            titem_load(get_mat(a, idc), rc, lane, wa); }
        for (; it < total; it += NGW) {
            const int nx = it + NGW; int rn = nx, idn = 0; f32x4 wn[8];
            if (nx < total) {
#pragma unroll
                for (int i = 0; i < 11; ++i) { if (idn == i && rn >= cnt[i]) { rn -= cnt[i]; idn = i + 1; } }
                titem_load(get_mat(a, idn), rn, lane, wn); }
            titem_finish(get_mat(a, idc), scr, (float*)(a.ws + OFF_VEC), rc, lane, wa);
            rc = rn; idc = idn;
#pragma unroll
            for (int i = 0; i < 8; ++i) wa[i] = wn[i];
        }
    }
}
__device__ __forceinline__ void prep_phase(const Args& a, unsigned char* lds) {
    int tid_ = threadIdx.x; asm volatile("" : "+v"(tid_));
    const int tid = tid_;
    const int gtid = blockIdx.x * NTHREADS + tid, gsz = gridDim.x * NTHREADS;
    prep_weights(a, lds, false, blockIdx.x * 8 + (tid >> 6), gridDim.x * 8);
    {
        const f32x4* x4 = (const f32x4*)a.in[0]; u32x4* xb = (u32x4*)(a.ws + OFF_YB);
        for (size_t i = gtid; i < (size_t)M * DM / 8; i += (size_t)8 * gsz) { f32x4 v[16];
#pragma unroll
            for (int k = 0; k < 8; ++k) { const size_t j = i + (size_t)k * gsz; const bool ok = j < (size_t)M * DM / 8; v[2 * k] = ok ? x4[2 * j] : (f32x4){0.f, 0.f, 0.f, 0.f}; v[2 * k + 1] = ok ? x4[2 * j + 1] : (f32x4){0.f, 0.f, 0.f, 0.f}; }
#pragma unroll
            for (int k = 0; k < 8; ++k) { const size_t j = i + (size_t)k * gsz; if (j < (size_t)M * DM / 8) xb[j] = pack8(v[2 * k], v[2 * k + 1]); } }
        const f32x4* p4 = (const f32x4*)a.in[1]; u32x4* pb = (u32x4*)(a.ws + OFF_PB);
        for (size_t i = gtid; i < (size_t)M * PLE / 8; i += (size_t)8 * gsz) { f32x4 v[16];
#pragma unroll
            for (int k = 0; k < 8; ++k) { const size_t j = i + (size_t)k * gsz; const bool ok = j < (size_t)M * PLE / 8; v[2 * k] = ok ? p4[2 * j] : (f32x4){0.f, 0.f, 0.f, 0.f}; v[2 * k + 1] = ok ? p4[2 * j + 1] : (f32x4){0.f, 0.f, 0.f, 0.f}; }
#pragma unroll
            for (int k = 0; k < 8; ++k) { const size_t j = i + (size_t)k * gsz; if (j < (size_t)M * PLE / 8) pb[j] = pack8(v[2 * k], v[2 * k + 1]); } }
    }
}
__device__ __forceinline__ void reduce_vec_phase(const Args& a, const int col0, const int col1, const bool with_cb) {
    int tid_ = threadIdx.x; asm volatile("" : "+v"(tid_));
    const int gtid = blockIdx.x * NTHREADS + tid_, gsz = gridDim.x * NTHREADS;
    float* vec = (float*)(a.ws + OFF_VEC);
    for (int col = col0 + gtid; col < col1; col += gsz) { float s1 = 0.f, s2 = 0.f;
#pragma unroll
        for (int ks = 0; ks < 16; ++ks) { s1 += vec[V_CPART + ((size_t)ks * NCV + col) * 2]; s2 += vec[V_CPART + ((size_t)ks * NCV + col) * 2 + 1]; }
        vec[V_C1 + col] = s1; vec[V_C2 + col] = s2; }
    if (with_cb) for (int i = gtid; i < 512; i += gsz) { float s = 0.f;
#pragma unroll
        for (int ks = 0; ks < 32; ++ks) s += vec[V_CBP + ks * 512 + i];
        vec[V_CB + i] = s; }
}

__device__ __forceinline__ float ret_log_gamma(int h) { return __logf(1.f - __builtin_amdgcn_exp2f(-5.f - (float)h)); }
namespace nsa {
typedef short bf16x8 __attribute__((ext_vector_type(8)));
typedef short s16x4 __attribute__((ext_vector_type(4)));
typedef float f32x16 __attribute__((ext_vector_type(16)));
typedef float f32x2_t __attribute__((ext_vector_type(2)));
typedef __bf16 bf16x2_t __attribute__((ext_vector_type(2)));
typedef short v4i16_t __attribute__((ext_vector_type(4)));
#define NLAS __attribute__((address_space(3)))
typedef NLAS const char* lds_cptr;
#define MFMA32(a, b, c) __builtin_amdgcn_mfma_f32_32x32x16_bf16((a), (b), (c), 0, 0, 0)
constexpr int L_K = 0, L_V = 16384, IMP_P = 132, L_SELM = 65536, L_WSF = L_SELM + 1024, L_OST = L_WSF + 8 * 512, L_IMP = L_OST, L_END = L_OST + 8 * 8192;
static_assert(L_END <= LDS_BYTES, "nsa LDS map");
constexpr float THR = 8.f;
__device__ __forceinline__ int crow(int r, int hi) { return (r & 3) + 8 * (r >> 2) + 4 * hi; }
__device__ __forceinline__ unsigned cvtpk(float lo, float hi) { f32x2_t v = {lo, hi}; bf16x2_t b = __builtin_convertvector(v, bf16x2_t); return __builtin_bit_cast(unsigned, b); }
__device__ __forceinline__ s16x4 vtr(lds_cptr p) { return __builtin_bit_cast(s16x4, __builtin_amdgcn_ds_read_tr16_b64_v4i16((NLAS v4i16_t*)p)); }
__device__ __forceinline__ float swapmax(float a) { auto rr = __builtin_amdgcn_permlane32_swap(__float_as_uint(a), __float_as_uint(a), false, false); return fmaxf(__uint_as_float(rr[0]), __uint_as_float(rr[1])); }
__device__ __forceinline__ float swapsum(float a) { auto rr = __builtin_amdgcn_permlane32_swap(__float_as_uint(a), __float_as_uint(a), false, false); return __uint_as_float(rr[0]) + __uint_as_float(rr[1]); }
__device__ __forceinline__ void kload(bf16x8 (&kf)[8], lds_cptr kb) {
#pragma unroll
    for (int d0 = 0; d0 < 4; ++d0) { kf[2 * d0] = *(const NLAS bf16x8*)(kb + d0 * 2048); kf[2 * d0 + 1] = *(const NLAS bf16x8*)(kb + d0 * 2048 + 512); }
}
__device__ __forceinline__ void vload(bf16x8 (&vf)[8], lds_cptr vp) {
#pragma unroll
    for (int d0 = 0; d0 < 2; ++d0)
#pragma unroll
        for (int ks = 0; ks < 4; ++ks) { const s16x4 lo = vtr(vp + d0 * 4096 + ks * 1024), hi = vtr(vp + d0 * 4096 + ks * 1024 + 512); vf[4 * d0 + ks] = __builtin_shufflevector(lo, hi, 0, 1, 2, 3, 4, 5, 6, 7); }
}
__device__ __forceinline__ void qkt_f(f32x16& p0, f32x16& p1, const bf16x8 (&kf)[8], const bf16x8 (&qr)[4]) {
    f32x16 z;
#pragma unroll
    for (int i = 0; i < 16; ++i) z[i] = 0.f;
    __builtin_amdgcn_s_setprio(1);
    p0 = MFMA32(kf[0], qr[0], z); p1 = MFMA32(kf[1], qr[0], z);
#pragma unroll
    for (int d0 = 1; d0 < 4; ++d0) { p0 = MFMA32(kf[2 * d0], qr[d0], p0); p1 = MFMA32(kf[2 * d0 + 1], qr[d0], p1); }
    __builtin_amdgcn_s_setprio(0);
}
__device__ __forceinline__ void pvmul_f(f32x16 (&o)[2], const bf16x8 (&vf)[8], const u32x4 (&pw)[4]) {
    __builtin_amdgcn_s_setprio(1);
#pragma unroll
    for (int ks = 0; ks < 4; ++ks) { o[0] = MFMA32(__builtin_bit_cast(bf16x8, pw[ks]), vf[ks], o[0]); o[1] = MFMA32(__builtin_bit_cast(bf16x8, pw[ks]), vf[4 + ks], o[1]); }
    __builtin_amdgcn_s_setprio(0);
}
__device__ __forceinline__ void qkt(f32x16& p0, f32x16& p1, lds_cptr kb, const bf16x8 (&qr)[4]) {
    bf16x8 kf[8]; kload(kf, kb); __builtin_amdgcn_sched_barrier(0); qkt_f(p0, p1, kf, qr);
}
__device__ __forceinline__ void packp(u32x4 (&pw)[4], const f32x16& p0, const f32x16& p1) {
    pw[0] = (u32x4){cvtpk(p0[0], p0[1]), cvtpk(p0[2], p0[3]), cvtpk(p0[4], p0[5]), cvtpk(p0[6], p0[7])};
    pw[1] = (u32x4){cvtpk(p0[8], p0[9]), cvtpk(p0[10], p0[11]), cvtpk(p0[12], p0[13]), cvtpk(p0[14], p0[15])};
    pw[2] = (u32x4){cvtpk(p1[0], p1[1]), cvtpk(p1[2], p1[3]), cvtpk(p1[4], p1[5]), cvtpk(p1[6], p1[7])};
    pw[3] = (u32x4){cvtpk(p1[8], p1[9]), cvtpk(p1[10], p1[11]), cvtpk(p1[12], p1[13]), cvtpk(p1[14], p1[15])};
}
__device__ __forceinline__ void pvmul(f32x16 (&o)[2], lds_cptr vp, const u32x4 (&pw)[4]) {
    bf16x8 vf[8]; vload(vf, vp); __builtin_amdgcn_sched_barrier(0); pvmul_f(o, vf, pw);
}
__device__ __forceinline__ float fsub_s(float a, float b) { float r; asm("v_sub_f32_e32 %0, %1, %2" : "=v"(r) : "v"(a), "v"(b)); return r; }
__device__ __forceinline__ float max3f(float a, float b, float c) { float r; asm("v_max3_f32 %0, %1, %2, %3" : "=v"(r) : "v"(a), "v"(b), "v"(c)); return r; }
__device__ __forceinline__ float max2f(float a, float b) { float r; asm("v_max_f32_e32 %0, %1, %2" : "=v"(r) : "v"(a), "v"(b)); return r; }
__device__ __forceinline__ void mfma_guard(f32x16& a, f32x16& b) { asm volatile("s_nop 15\n\ts_nop 7" : "+v"(a), "+v"(b)); }
__device__ __forceinline__ float sub_rowmax(f32x16& p0, f32x16& p1, float ref) {
#pragma unroll
    for (int r = 0; r < 16; ++r) { p0[r] = fsub_s(p0[r], ref); p1[r] = fsub_s(p1[r], ref); }
    float a = max3f(p0[0], p0[1], p1[0]), b = max3f(p0[2], p0[3], p1[1]); a = max3f(a, p1[2], p1[3]);
#pragma unroll
    for (int r = 4; r < 16; r += 4) { a = max3f(a, p0[r], p0[r + 1]); b = max3f(b, p0[r + 2], p0[r + 3]); a = max3f(a, p1[r], p1[r + 1]); b = max3f(b, p1[r + 2], p1[r + 3]); }
    return swapmax(max2f(a, b));
}
__device__ __forceinline__ void maskp(f32x16& p0, f32x16& p1, int lo, int hl, int hi) {
    const float NINF = -__builtin_inff();
    int la = lo - 4 * hi, ha = hl - 4 * hi;
    asm volatile("" : "+v"(la), "+v"(ha));
#pragma unroll
    for (int r = 0; r < 16; ++r) { const int cr = (r & 3) + 8 * (r >> 2);
        p0[r] = (cr >= la && cr <= ha) ? p0[r] : NINF; p1[r] = (cr + 32 >= la && cr + 32 <= ha) ? p1[r] : NINF; }
}
__device__ __forceinline__ float rowmax_a(const f32x16& p0, const f32x16& p1) {
    float a = max3f(p0[0], p0[1], p1[0]), b = max3f(p0[2], p0[3], p1[1]); a = max3f(a, p1[2], p1[3]);
#pragma unroll
    for (int r = 4; r < 16; r += 4) { a = max3f(a, p0[r], p0[r + 1]); b = max3f(b, p0[r + 2], p0[r + 3]); a = max3f(a, p1[r], p1[r + 1]); b = max3f(b, p1[r + 2], p1[r + 3]); }
    return swapmax(max2f(a, b));
}
__device__ __forceinline__ float rowmax32(const f32x16& p0, const f32x16& p1) {
    float a = fmaxf(p0[0], p1[0]);
#pragma unroll
    for (int r = 1; r < 16; ++r) a = fmaxf(a, fmaxf(p0[r], p1[r]));
    return swapmax(a);
}
__device__ __forceinline__ void softmax_rel(f32x16& p0, f32x16& p1, float& m, float& l, f32x16 (&o)[2], float* wsf, int r32, int hi, bool en, bool first) {
    mfma_guard(p0, p1);
    if (first) { const float rm0 = rowmax32(p0, p1); m = (rm0 > -3e38f) ? rm0 : 0.f; }
    const float rm = sub_rowmax(p0, p1, en ? m : __builtin_inff());
    if (__any(rm > THR)) {
        const float dl = fmaxf(rm, 0.f), al = __builtin_amdgcn_exp2f(-dl);
        m += dl; l *= al;
#pragma unroll
        for (int r = 0; r < 16; ++r) { p0[r] -= dl; p1[r] -= dl; }
        if (hi == 0) wsf[r32] = al;
        asm volatile("s_waitcnt lgkmcnt(0)" ::: "memory");
#pragma unroll
        for (int r = 0; r < 16; ++r) { const float f = wsf[4 * hi + (r & 3) + 8 * (r >> 2)]; o[0][r] *= f; o[1][r] *= f; }
        asm volatile("s_waitcnt lgkmcnt(0)" ::: "memory");
    }
    float s = 0.f;
#pragma unroll
    for (int r = 0; r < 16; ++r) { p0[r] = __builtin_amdgcn_exp2f(p0[r]); s += p0[r]; p1[r] = __builtin_amdgcn_exp2f(p1[r]); s += p1[r]; }
    l += s;
}
__device__ __forceinline__ void stats_rel(f32x16& p0, f32x16& p1, float& m, float& l, bool first) {
    mfma_guard(p0, p1);
    if (first) { const float rm0 = rowmax32(p0, p1); m = (rm0 > -3e38f) ? rm0 : 0.f; }
    const float rm = sub_rowmax(p0, p1, m);
    if (__any(rm > THR)) {
        const float dl = fmaxf(rm, 0.f); m += dl; l *= __builtin_amdgcn_exp2f(-dl);
#pragma unroll
        for (int r = 0; r < 16; ++r) { p0[r] -= dl; p1[r] -= dl; }
    }
    float s = 0.f;
#pragma unroll
    for (int r = 0; r < 16; ++r) { s += __builtin_amdgcn_exp2f(p0[r]); s += __builtin_amdgcn_exp2f(p1[r]); }
    l += s;
}
__device__ __forceinline__ void glds16(const void* gsrc, unsigned lds_dst) { unsigned keep;
    asm volatile("s_mov_b32 %0, m0\n\ts_mov_b32 m0, %2\n\ts_nop 0\n\tglobal_load_lds_dwordx4 %1, off\n\ts_mov_b32 m0, %0" : "=&s"(keep) : "v"(gsrc), "s"(lds_dst) : "memory"); }
__device__ __forceinline__ int nsa_ksoff() { int t_ = threadIdx.x; asm volatile("" : "+v"(t_)); return (t_ & 63) * 64 + (t_ >> 6) * 8; }
__device__ __forceinline__ int nsa_vsoff() { int t_ = threadIdx.x; asm volatile("" : "+v"(t_)); const int l_ = t_ & 63, w_ = t_ >> 6; return (16 * (w_ & 3) + (l_ >> 2)) * 64 + (w_ >> 2) * 32 + (l_ & 3) * 8; }
__device__ __forceinline__ float nsa_gate(const float* gates, int b, int t0, int g, int k) {
    int t_ = threadIdx.x; asm volatile("" : "+v"(t_));
    const int r32_ = t_ & 31, w_ = t_ >> 6;
    return gates[((size_t)b * SEQ + t0 + 8 * w_ + (r32_ >> 2)) * 24 + g * 12 + (r32_ & 3) * 3 + k];
}
struct Ptrs { const bf16_t* qn; const bf16_t* kv; const bf16_t* kcmp; const float* gates; bf16_t* mix; };

__device__ __forceinline__ void unit(const Ptrs& P, int bg, int it, unsigned char* lds, NLAS unsigned char* lds3) {
    int tid_ = threadIdx.x; asm volatile("" : "+v"(tid_));
    const int tid = tid_, lane = tid & 63, wid = __builtin_amdgcn_readfirstlane(tid >> 6), r32 = lane & 31, hi = lane >> 5;
    const int b = bg >> 1, g = bg & 1, t0 = it * 64, cur = it;
    const int tl = 8 * wid + (r32 >> 2), head = r32 & 3;
    const size_t rowg = (size_t)b * SEQ + t0 + tl;
    bf16x8 qr[4];
    { const bf16_t* qp = P.qn + rowg * 512 + g * 256 + head * 64 + hi * 8;
#pragma unroll
      for (int d0 = 0; d0 < 4; ++d0) qr[d0] = *(const bf16x8*)(qp + d0 * 16); }
    const lds_cptr kb0 = (lds_cptr)lds3 + L_K + hi * 1024 + r32 * 16;
    const lds_cptr vp0 = (lds_cptr)lds3 + L_V + ((lane >> 4) & 1) * 32 + (lane & 3) * 8 + (4 * hi + ((lane & 15) >> 2)) * 64;
    float* wsf = (float*)(lds + L_WSF + wid * 512);
    float* ost = (float*)(lds + L_OST + wid * 8192);
    float* imp = (float*)(lds + L_IMP);
    unsigned short* selm = (unsigned short*)(lds + L_SELM);
#define ksoff nsa_ksoff()
#define vsoff nsa_vsoff()
#define NSA_GT(k) nsa_gate(P.gates, b, t0, g, (k))
    const unsigned dma0 = (unsigned)(uintptr_t)lds + wid * 1024;
#define NSA_DMA2(Kb, Vb, tile, two, slot) do { const unsigned d_ = (unsigned)__builtin_amdgcn_readfirstlane(dma0 + (slot) * 32768); \
        glds16((Kb) + (size_t)(tile) * 4096 + ksoff, d_); glds16((Vb) + (size_t)(tile) * 4096 + vsoff, d_ + 16384); \
        if (two) { glds16((Kb) + (size_t)((tile) + 1) * 4096 + ksoff, d_ + 8192); glds16((Vb) + (size_t)((tile) + 1) * 4096 + vsoff, d_ + 24576); } } while (0)
#define NSA_DMAWAIT() asm volatile("s_waitcnt vmcnt(0)" ::: "memory")
#define NSA_COMBINE(first, facv) do { if (hi == 0) wsf[32 + r32] = (facv); asm volatile("s_waitcnt lgkmcnt(0)" ::: "memory"); \
        { const float* wb_ = wsf + 32 + 4 * hi; float* ob_ = ost + 256 * hi + r32; \
        _Pragma("unroll") for (int r = 0; r < 16; ++r) { const float f_ = wb_[(r & 3) + 8 * (r >> 2)]; \
            _Pragma("unroll") for (int d0 = 0; d0 < 2; ++d0) { float* op_ = ob_ + ((r & 3) + 8 * (r >> 2)) * 64 + 32 * d0; *op_ = ((first) ? 0.f : *op_) + o[d0][r] * f_; } } } \
        asm volatile("s_waitcnt lgkmcnt(0)" ::: "memory"); } while (0)

    f32x16 o[2], p0, p1; u32x4 pw[4];
    const bf16_t* Kc = P.kcmp + (size_t)bg * 512 * 64; const bf16_t* Vc = Kc + KCMP_J;
    {
        const int t = t0 + tl; const int ncl = (t >= 31) ? ((t - 31) >> 4) + 1 : 0;
        const int NT = (4 * it + 3 + 63) >> 6, NI = (NT + 1) >> 1;
        float m = 0.f, l = 0.f;
        NSA_DMA2(Kc, Vc, 0, NT > 1, 0); NSA_DMAWAIT(); __syncthreads();
        for (int n = 0; n < NI; ++n) {
            const int slot = n & 1;
            if (n + 1 < NI) NSA_DMA2(Kc, Vc, 2 * n + 2, 2 * n + 3 < NT, slot ^ 1);
#pragma unroll
            for (int sub = 0; sub < 2; ++sub) {
                const int jb = 2 * n + sub;
                if (jb < NT) {
                    qkt(p0, p1, kb0 + slot * 32768 + sub * 8192, qr);
                    if (__any(ncl - 64 * jb < 64)) maskp(p0, p1, 0, ncl - 64 * jb - 1, hi);
                    stats_rel(p0, p1, m, l, jb == 0);
                }
            }
            NSA_DMAWAIT(); __syncthreads();
        }
        l = swapsum(l);
        const float m2 = (l > 0.f) ? m + __builtin_amdgcn_logf(l) : m;
        for (int i = lane; i < 8 * IMP_P; i += 64) imp[8 * wid * IMP_P + i] = 0.f;
        bf16x8 ovf[4];
#pragma unroll
        for (int ks = 0; ks < 4; ++ks)
#pragma unroll
            for (int j = 0; j < 8; ++j) { const int k4 = 4 * ks + 2 * (j >> 2) + hi, pos = j & 3;
                ovf[ks][j] = (short)((r32 == k4) ? ((pos == 3) ? 0x3F00 : 0x3F80) : ((r32 == k4 + 1 && pos == 3) ? 0x3F00 : 0)); }
#pragma unroll
        for (int i = 0; i < 16; ++i) { o[0][i] = 0.f; o[1][i] = 0.f; }
        NSA_DMA2(Kc, Vc, 0, NT > 1, 0); NSA_DMAWAIT(); __syncthreads();
        for (int n = 0; n < NI; ++n) {
            const int slot = n & 1;
            if (n + 1 < NI) NSA_DMA2(Kc, Vc, 2 * n + 2, 2 * n + 3 < NT, slot ^ 1);
#pragma unroll
            for (int sub = 0; sub < 2; ++sub) {
                const int jb = 2 * n + sub;
                if (jb < NT) {
                    qkt(p0, p1, kb0 + slot * 32768 + sub * 8192, qr);
                    if (__any(ncl - 64 * jb < 64)) maskp(p0, p1, 0, ncl - 64 * jb - 1, hi);
                    mfma_guard(p0, p1);
#pragma unroll
                    for (int r = 0; r < 16; ++r) { p0[r] = __builtin_amdgcn_exp2f(fsub_s(p0[r], m2)); p1[r] = __builtin_amdgcn_exp2f(fsub_s(p1[r], m2)); }
                    packp(pw, p0, p1);
                    pvmul(o, vp0 + slot * 32768 + sub * 8192, pw);
                    if (cur >= 16) {
                        f32x16 ia;
#pragma unroll
                        for (int i = 0; i < 16; ++i) ia[i] = 0.f;
#pragma unroll
                        for (int ks = 0; ks < 4; ++ks) ia = MFMA32(__builtin_bit_cast(bf16x8, pw[ks]), ovf[ks], ia);
                        if (r32 <= 16) {
                            { float* ib = imp + (8 * wid + hi) * IMP_P + jb * 16 + r32;
#pragma unroll
                            for (int i = 0; i < 4; ++i) ib[2 * i * IMP_P] += (ia[4 * i] + ia[4 * i + 1]) + (ia[4 * i + 2] + ia[4 * i + 3]); }
                        }
                    }
                }
            }
            NSA_DMAWAIT(); __syncthreads();
        }
    }
    {
        const bf16_t* ks_ = P.kv + 2 * KVSZ + (size_t)bg * SEQ * 64 + ksoff; const bf16_t* vs_ = P.kv + 3 * KVSZ + (size_t)bg * SEQ * 64 + vsoff;
        glds16(ks_, (unsigned)__builtin_amdgcn_readfirstlane(dma0)); glds16(vs_, (unsigned)__builtin_amdgcn_readfirstlane(dma0 + 24576));
        if (cur > 0) glds16(ks_ + 4096, (unsigned)__builtin_amdgcn_readfirstlane(dma0 + 8192));
        if (cur > 1) glds16(ks_ + 8192, (unsigned)__builtin_amdgcn_readfirstlane(dma0 + 16384));
    }
    {
        const int j = lane >> 3, sub = lane & 7, tok = 8 * wid + j;
        unsigned key[16];
#pragma unroll
        for (int i = 0; i < 16; ++i) { const int s = sub * 16 + i; const float v = imp[tok * IMP_P + s];
            const bool forced = (s == 0) | (s == cur) | (s == cur - 1);
            key[i] = (s > cur) ? 0u : (forced ? (0x7F800000u | (unsigned)(127 - s)) : ((__float_as_uint(v) & 0xFFFFFF80u) | (unsigned)(127 - s))); }
        unsigned selbits = 0u;
        if (cur < 16) {
#pragma unroll
            for (int i = 0; i < 16; ++i) selbits |= (key[i] != 0u) ? (1u << i) : 0u;
        } else {
#pragma nounroll
            for (int itr = 0; itr < 16; ++itr) {
                unsigned mx = key[0];
#pragma unroll
                for (int i = 1; i < 16; ++i) mx = key[i] > mx ? key[i] : mx;
                { unsigned w = (unsigned)__builtin_amdgcn_update_dpp(0, (int)mx, 0xB1, 0xF, 0xF, false); mx = w > mx ? w : mx;
                  w = (unsigned)__builtin_amdgcn_update_dpp(0, (int)mx, 0x4E, 0xF, 0xF, false); mx = w > mx ? w : mx;
                  w = (unsigned)__builtin_amdgcn_update_dpp(0, (int)mx, 0x141, 0xF, 0xF, false); mx = w > mx ? w : mx; }
#pragma unroll
                for (int i = 0; i < 16; ++i) key[i] = (key[i] == mx) ? 0u : key[i];
            }
#pragma unroll
            for (int i = 0; i < 16; ++i) selbits |= (key[i] == 0u && sub * 16 + i <= cur) ? (1u << i) : 0u;
        }
        selm[tok * 8 + sub] = (unsigned short)selbits;
    }
    __syncthreads();
    NSA_COMBINE(true, NSA_GT(0));
    {
        const bf16_t* Kb = P.kv + 2 * KVSZ + (size_t)bg * SEQ * 64; const bf16_t* Vb = P.kv + 3 * KVSZ + (size_t)bg * SEQ * 64;
        const unsigned* mwp = (const unsigned*)(selm + tl * 8); unsigned mwc = mwp[0];
        const int NT = cur + 1;
        constexpr int SLOTB = 8192, SV = 3 * SLOTB;
        const bf16_t* ksrc = Kb + ksoff; const bf16_t* vsrc = Vb + vsoff;
        const lds_cptr kq0 = kb0; const lds_cptr vq0 = vp0 + (SV - L_V);
#define SEL_DMA_K(t, slot) glds16(ksrc + (size_t)(t) * 4096, (unsigned)__builtin_amdgcn_readfirstlane(dma0 + (slot)))
#define SEL_DMA_V(t, slot) glds16(vsrc + (size_t)(t) * 4096, (unsigned)__builtin_amdgcn_readfirstlane(dma0 + SV + (slot)))
#define SEL_WAIT_BAR(N) asm volatile("s_waitcnt vmcnt(" #N ") lgkmcnt(0)\n\ts_barrier" ::: "memory")
#define SEL_SBAR() __builtin_amdgcn_sched_barrier(0)
#define SEL_PIN(x) asm volatile("" : "+v"(x))
#define SEL_EN(t) ((mwc >> ((t) & 31)) & 1u)
        float mhat = 0.f, l = 0.f; bool resc = false; unsigned enp = ~0u;
        f32x16 negm;
#pragma unroll
        for (int i = 0; i < 16; ++i) { o[0][i] = 0.f; o[1][i] = 0.f; }
        const f32x16 zero16 = {0.f, 0.f, 0.f, 0.f, 0.f, 0.f, 0.f, 0.f, 0.f, 0.f, 0.f, 0.f, 0.f, 0.f, 0.f, 0.f};
        f32x16 pA0, pA1, pB0, pB1; bf16x8 kf[8]; s16x4 vlo[8], vhi[8]; u32x4 pw0, pw1, pw2, pw3;
        int sl_prev = 0, sl_cur = 0, sl_next = SLOTB;
#define SEL_ROT() do { sl_prev = sl_cur; sl_cur = sl_next; sl_next = (sl_next == 2 * SLOTB) ? 0 : sl_next + SLOTB; } while (0)
#define SEL_KLD2(base, d0) do { kf[2 * (d0)] = *(const NLAS bf16x8*)((base) + (d0) * 2048); kf[2 * (d0) + 1] = *(const NLAS bf16x8*)((base) + (d0) * 2048 + 512); } while (0)
#define SEL_EX(v) __builtin_amdgcn_exp2f(fsub_s((v), mref))
#define SEL_RESC() do { if (resc) { _Pragma("unroll") for (int d_ = 0; d_ < 2; ++d_) _Pragma("unroll") for (int r = 0; r < 16; ++r) o[d_][r] *= wsf[crow(r, hi)]; } } while (0)
        SEL_WAIT_BAR(0);
#pragma unroll
        for (int d0 = 0; d0 < 4; ++d0) SEL_KLD2(kq0, d0);
        pA0 = MFMA32(kf[0], qr[0], zero16); pA1 = MFMA32(kf[1], qr[0], zero16); pA0 = MFMA32(kf[2], qr[1], pA0); pA1 = MFMA32(kf[3], qr[1], pA1);
        pA0 = MFMA32(kf[4], qr[2], pA0); pA1 = MFMA32(kf[5], qr[2], pA1); pA0 = MFMA32(kf[6], qr[3], pA0); pA1 = MFMA32(kf[7], qr[3], pA1);
        if (NT == 1) maskp(pA0, pA1, 0, tl, hi);
        { mfma_guard(pA0, pA1); const float rm0 = rowmax_a(pA0, pA1); mhat = rm0; const float mref = mhat;
#pragma unroll
          for (int r = 0; r < 16; ++r) { pA0[r] = SEL_EX(pA0[r]); pA1[r] = SEL_EX(pA1[r]); }
#pragma unroll
          for (int r = 0; r < 16; ++r) negm[r] = -mhat;
          SEL_PIN(negm); }
        SEL_WAIT_BAR(0);
        if (NT > 3) SEL_DMA_K(3, 0); if (NT > 1) SEL_DMA_V(1, SLOTB); SEL_ROT();
        if (NT > 1) {
#pragma unroll
            for (int d0 = 0; d0 < 4; ++d0) SEL_KLD2(kq0 + sl_cur, d0);
        }
        if (NT > 3) SEL_WAIT_BAR(2); else SEL_WAIT_BAR(0);
#define SEL_PKW(Pv, i) (cvtpk(Pv[i], Pv[(i) + 1]) & enp)
#define SEL_PAF(k) __builtin_bit_cast(bf16x8, pw##k)
#define SEL_VFR(i) __builtin_shufflevector(vlo[i], vhi[i], 0, 1, 2, 3, 4, 5, 6, 7)
#define SEL_VRD(i) do { vlo[i] = vtr(vp_ + (((i) >> 2) * 4096 + ((i) & 3) * 1024)); vhi[i] = vtr(vp_ + (((i) >> 2) * 4096 + ((i) & 3) * 1024 + 512)); } while (0)
#define SEL_KRD(G, d0) do { if (G) { SEL_KLD2(kq0 + sl_next, d0); SEL_SBAR(); } } while (0)
#define SEL_GAPA(MF, a0, a1, a2, a3, W0, W1, PW) do { MF; sacc += a0; sacc += a1; sacc += a2; sacc += a3; W0; W1; SEL_PIN(PW); SEL_PIN(sacc); SEL_SBAR(); } while (0)
#define SEL_GAPB(MF, X, i) do { MF; X[i] = __builtin_amdgcn_exp2f(X[i]); X[(i) + 1] = __builtin_amdgcn_exp2f(X[(i) + 1]); X[(i) + 2] = __builtin_amdgcn_exp2f(X[(i) + 2]); X[(i) + 3] = __builtin_amdgcn_exp2f(X[(i) + 3]); SEL_PIN(X); SEL_SBAR(); } while (0)
#define SEL_STEP(C0, C1, P0, P1, t, MASK, GK, GV, GL) do { SEL_SBAR(); \
        const lds_cptr vp_ = vq0 + sl_prev; \
        SEL_VRD(0); SEL_SBAR(); float sacc = P0[0] + P0[1]; \
                            SEL_GAPA(C0 = MFMA32(kf[0], qr[0], negm), P0[2], P0[3], P0[4], P0[5],     pw0[0] = SEL_PKW(P0, 0),  pw0[1] = SEL_PKW(P0, 2),  pw0); \
        SEL_VRD(4); SEL_SBAR(); SEL_GAPA(C1 = MFMA32(kf[1], qr[0], negm), P0[6], P0[7], P0[8], P0[9],     pw0[2] = SEL_PKW(P0, 4),  pw0[3] = SEL_PKW(P0, 6),  pw0); \
        SEL_VRD(1); SEL_SBAR(); SEL_GAPA(C0 = MFMA32(kf[2], qr[1], C0),    P0[10], P0[11], P0[12], P0[13], pw1[0] = SEL_PKW(P0, 8),  pw1[1] = SEL_PKW(P0, 10), pw1); \
        SEL_VRD(5); SEL_SBAR(); SEL_GAPA(C1 = MFMA32(kf[3], qr[1], C1),    P0[14], P0[15], P1[0], P1[1],   pw1[2] = SEL_PKW(P0, 12), pw1[3] = SEL_PKW(P0, 14), pw1); \
        SEL_VRD(2); SEL_SBAR(); SEL_GAPA(C0 = MFMA32(kf[4], qr[2], C0),    P1[2], P1[3], P1[4], P1[5],     pw2[0] = SEL_PKW(P1, 0),  pw2[1] = SEL_PKW(P1, 2),  pw2); \
        SEL_VRD(6); SEL_SBAR(); SEL_GAPA(C1 = MFMA32(kf[5], qr[2], C1),    P1[6], P1[7], P1[8], P1[9],     pw2[2] = SEL_PKW(P1, 4),  pw2[3] = SEL_PKW(P1, 6),  pw2); \
        SEL_VRD(3); SEL_SBAR(); SEL_GAPA(C0 = MFMA32(kf[6], qr[3], C0),    P1[10], P1[11], P1[12], P1[13], pw3[0] = SEL_PKW(P1, 8),  pw3[1] = SEL_PKW(P1, 10), pw3); \
        SEL_VRD(7); SEL_SBAR(); SEL_GAPA(C1 = MFMA32(kf[7], qr[3], C1),    P1[14], P1[15], 0.f, 0.f,       pw3[2] = SEL_PKW(P1, 12), pw3[3] = SEL_PKW(P1, 14), pw3); \
        l += __uint_as_float(__float_as_uint(sacc) & enp); \
        if (GK) SEL_DMA_K((t) + 3, sl_cur); if (GV) SEL_DMA_V((t) + 1, sl_next); \
        if ((MASK) && (t) == NT - 1) maskp(C0, C1, 0, tl, hi); \
        if (((t) & 31) == 0) mwc = mwp[(t) >> 5]; \
        const bool en_ = SEL_EN(t) != 0u; \
        { mfma_guard(C0, C1); const float rmx = rowmax_a(C0, C1); const float rm = en_ ? rmx : -__builtin_inff(); resc = false; \
          if (__builtin_expect(__any(rm > THR), 0)) { const float dl = fmaxf(rm, 0.f); mhat += dl; \
              const float f = __builtin_amdgcn_exp2f(-dl); l *= f; if (hi == 0) wsf[r32] = f; resc = true; \
              _Pragma("unroll") for (int r = 0; r < 16; ++r) { C0[r] -= dl; C1[r] -= dl; negm[r] = -mhat; } SEL_PIN(negm); } } \
        enp = en_ ? ~0u : 0u; SEL_SBAR(); \
        SEL_GAPB(o[0] = MFMA32(SEL_PAF(0), SEL_VFR(0), o[0]), C0, 0);                  SEL_GAPB(o[1] = MFMA32(SEL_PAF(0), SEL_VFR(4), o[1]), C0, 4); \
        SEL_KRD(GL, 0); SEL_GAPB(o[0] = MFMA32(SEL_PAF(1), SEL_VFR(1), o[0]), C0, 8);  SEL_KRD(GL, 1); SEL_GAPB(o[1] = MFMA32(SEL_PAF(1), SEL_VFR(5), o[1]), C0, 12); \
        SEL_KRD(GL, 2); SEL_GAPB(o[0] = MFMA32(SEL_PAF(2), SEL_VFR(2), o[0]), C1, 0);  SEL_KRD(GL, 3); SEL_GAPB(o[1] = MFMA32(SEL_PAF(2), SEL_VFR(6), o[1]), C1, 4); \
        SEL_GAPB(o[0] = MFMA32(SEL_PAF(3), SEL_VFR(3), o[0]), C1, 8);                  SEL_GAPB(o[1] = MFMA32(SEL_PAF(3), SEL_VFR(7), o[1]), C1, 12); \
        } while (0)
#define SEL_ENDW(tt) do { if ((tt) + 3 < NT) { SEL_WAIT_BAR(2); } else if ((tt) + 2 < NT) { SEL_WAIT_BAR(1); } else { SEL_WAIT_BAR(0); } } while (0)
        int t = 1;
        for (; t + 5 < NT; t += 2) {
            SEL_STEP(pB0, pB1, pA0, pA1, t, false, true, true, true);     SEL_WAIT_BAR(2); SEL_RESC(); SEL_ROT();
            SEL_STEP(pA0, pA1, pB0, pB1, t + 1, false, true, true, true); SEL_WAIT_BAR(2); SEL_RESC(); SEL_ROT();
        }
        for (; t + 1 < NT; t += 2) {
            SEL_STEP(pB0, pB1, pA0, pA1, t, true, (t + 3 < NT), (t + 1 < NT), (t + 1 < NT));         SEL_ENDW(t);     SEL_RESC(); SEL_ROT();
            SEL_STEP(pA0, pA1, pB0, pB1, t + 1, true, (t + 4 < NT), (t + 2 < NT), (t + 2 < NT));     SEL_ENDW(t + 1); SEL_RESC(); SEL_ROT();
        }
        int vslot = sl_cur;
        if (t < NT) { SEL_STEP(pB0, pB1, pA0, pA1, t, true, false, false, false); SEL_RESC(); }
        else { pB0 = pA0; pB1 = pA1; vslot = sl_prev; }
        { float sacc = pB0[0] + pB0[1];
#pragma unroll
          for (int r = 2; r < 16; ++r) sacc += pB0[r];
#pragma unroll
          for (int r = 0; r < 16; ++r) sacc += pB1[r];
          l += __uint_as_float(__float_as_uint(sacc) & enp);
          pw0 = (u32x4){SEL_PKW(pB0, 0), SEL_PKW(pB0, 2), SEL_PKW(pB0, 4), SEL_PKW(pB0, 6)}; pw1 = (u32x4){SEL_PKW(pB0, 8), SEL_PKW(pB0, 10), SEL_PKW(pB0, 12), SEL_PKW(pB0, 14)};
          pw2 = (u32x4){SEL_PKW(pB1, 0), SEL_PKW(pB1, 2), SEL_PKW(pB1, 4), SEL_PKW(pB1, 6)}; pw3 = (u32x4){SEL_PKW(pB1, 8), SEL_PKW(pB1, 10), SEL_PKW(pB1, 12), SEL_PKW(pB1, 14)};
          const lds_cptr vp_ = vq0 + vslot;
#pragma unroll
          for (int i = 0; i < 8; ++i) SEL_VRD(i);
          o[0] = MFMA32(SEL_PAF(0), SEL_VFR(0), o[0]); o[1] = MFMA32(SEL_PAF(0), SEL_VFR(4), o[1]); o[0] = MFMA32(SEL_PAF(1), SEL_VFR(1), o[0]); o[1] = MFMA32(SEL_PAF(1), SEL_VFR(5), o[1]);
          o[0] = MFMA32(SEL_PAF(2), SEL_VFR(2), o[0]); o[1] = MFMA32(SEL_PAF(2), SEL_VFR(6), o[1]); o[0] = MFMA32(SEL_PAF(3), SEL_VFR(3), o[0]); o[1] = MFMA32(SEL_PAF(3), SEL_VFR(7), o[1]); }
        l = swapsum(l);
        NSA_COMBINE(false, NSA_GT(1) / l);
        __syncthreads();
#undef SEL_DMA_K
#undef SEL_DMA_V
#undef SEL_WAIT_BAR
#undef SEL_SBAR
#undef SEL_PIN
#undef SEL_EN
#undef SEL_ROT
#undef SEL_KLD2
#undef SEL_EX
#undef SEL_RESC
#undef SEL_PKW
#undef SEL_PAF
#undef SEL_VFR
#undef SEL_VRD
#undef SEL_KRD
#undef SEL_GAPA
#undef SEL_GAPB
#undef SEL_STEP
#undef SEL_ENDW
    }
    {
        const bf16_t* Kb = P.kv + 4 * KVSZ + (size_t)bg * SEQ * 64; const bf16_t* Vb = P.kv + 5 * KVSZ + (size_t)bg * SEQ * 64;
        float m = 0.f, l = 0.f;
#pragma unroll
        for (int i = 0; i < 16; ++i) { o[0][i] = 0.f; o[1][i] = 0.f; }
        const int j0 = (cur >= 8) ? cur - 8 : 0, NT = cur - j0 + 1, NI = (NT + 1) >> 1;
        if (NT > 1) NSA_DMA2(Kb, Vb, cur - 1, true, 0); else NSA_DMA2(Kb, Vb, cur, false, 0);
        NSA_DMAWAIT(); __syncthreads();
        for (int n = 0; n < NI; ++n) {
            const int slot = n & 1;
            if (n + 1 < NI) { const int ja1 = cur - 2 * n - 2; if (ja1 - 1 >= j0) NSA_DMA2(Kb, Vb, ja1 - 1, true, slot ^ 1); else NSA_DMA2(Kb, Vb, ja1, false, slot ^ 1); }
            {
                const int ja = cur - 2 * n, jb = ja - 1; const bool hasB = jb >= j0; const int offA = hasB ? 8192 : 0;
                bf16x8 kf[8], vf[8];
                kload(kf, kb0 + slot * 32768 + offA); vload(vf, vp0 + slot * 32768 + offA); __builtin_amdgcn_sched_barrier(0); qkt_f(p0, p1, kf, qr); __builtin_amdgcn_sched_barrier(0);
                if (hasB) kload(kf, kb0 + slot * 32768);
                { const int lo = (ja == cur - 8) ? tl + 1 : 0, hl = (ja == cur) ? tl : 63;
                  if (ja == cur - 8 || ja == cur) maskp(p0, p1, lo, hl, hi); }
                softmax_rel(p0, p1, m, l, o, wsf, r32, hi, true, n == 0);
                packp(pw, p0, p1);
                pvmul_f(o, vf, pw);
                if (hasB) {
                    vload(vf, vp0 + slot * 32768); __builtin_amdgcn_sched_barrier(0);
                    qkt_f(p0, p1, kf, qr);
                    if (jb == cur - 8) maskp(p0, p1, tl + 1, 63, hi);
                    softmax_rel(p0, p1, m, l, o, wsf, r32, hi, true, false);
                    packp(pw, p0, p1);
                    pvmul_f(o, vf, pw);
                }
            }
            NSA_DMAWAIT(); __syncthreads();
        }
        l = swapsum(l);
        NSA_COMBINE(false, NSA_GT(2) / l);
    }
    {
        const int row = lane >> 1, half = lane & 1;
        const float* src = ost + row * 64 + half * 32;
        bf16_t* dst = P.mix + ((size_t)b * SEQ + t0 + 8 * wid + (row >> 2)) * 1024 + g * 256 + (row & 3) * 64 + half * 32;
#pragma unroll
        for (int i = 0; i < 4; ++i) *(u32x4*)(dst + 8 * i) = pack8(*(const f32x4*)(src + 8 * i), *(const f32x4*)(src + 8 * i + 4));
    }
    __syncthreads();
#undef NSA_DMA2
#undef NSA_DMAWAIT
#undef NSA_COMBINE
#undef NSA_GT
#undef ksoff
#undef vsoff
}
}

namespace ret {
using nsa::bf16x8; using nsa::s16x4; using nsa::f32x16; using nsa::lds_cptr; using nsa::vtr; using nsa::crow; using nsa::cvtpk;
__device__ __forceinline__ int timg(int j, int c) { return ((c >> 5) * 8 + (j >> 4)) * 1024 + (j & 15) * 64 + (c & 31) * 2; }
__device__ __forceinline__ bf16x8 trfrag(lds_cptr p) { const s16x4 lo = vtr(p), hi = vtr(p + 512); return __builtin_shufflevector(lo, hi, 0, 1, 2, 3, 4, 5, 6, 7); }
__device__ __forceinline__ void kv_unit(const bf16_t* kr, const bf16_t* vr, float* kvT, int unit, unsigned char* lds, NLAS unsigned char* lds3) {
    int tid_ = threadIdx.x; asm volatile("" : "+v"(tid_));
    const int tid = tid_, lane = tid & 63, wid = __builtin_amdgcn_readfirstlane(tid >> 6), r32 = lane & 31, hi = lane >> 5;
    const int h = (unit >> 6) & 3; const float l2g = __builtin_amdgcn_logf(1.f - __builtin_amdgcn_exp2f(-5.f - (float)h));
    const size_t base = (size_t)unit * 16384;
#pragma unroll
    for (int q = 0; q < 4; ++q) { const int c = tid + 512 * q, j = c >> 4, c8 = (c & 15) * 8;
        const u32x4 vv = *(const u32x4*)(vr + base + (size_t)c * 8), kk = *(const u32x4*)(kr + base + (size_t)c * 8);
        const float z = __builtin_amdgcn_exp2f((127.f - (float)j) * l2g);
        u32x4 kz; kz.x = cvtpk(bflo(kk.x) * z, bfhi(kk.x) * z); kz.y = cvtpk(bflo(kk.y) * z, bfhi(kk.y) * z); kz.z = cvtpk(bflo(kk.z) * z, bfhi(kk.z) * z); kz.w = cvtpk(bflo(kk.w) * z, bfhi(kk.w) * z);
        *(u32x4*)(lds + timg(j, c8)) = vv; *(u32x4*)(lds + 32768 + timg(j, c8)) = kz; }
    __syncthreads();
    const int eb = wid >> 1, dh = wid & 1;
    const lds_cptr lp = (lds_cptr)lds3 + ((lane >> 4) & 1) * 32 + (lane & 3) * 8 + (4 * hi + ((lane & 15) >> 2)) * 64;
    f32x16 acc[2];
#pragma unroll
    for (int i = 0; i < 16; ++i) { acc[0][i] = 0.f; acc[1][i] = 0.f; }
#pragma unroll
    for (int ks = 0; ks < 8; ++ks) {
        const bf16x8 af = trfrag(lp + (eb * 8 + ks) * 1024);
#pragma unroll
        for (int db = 0; db < 2; ++db) { const bf16x8 bfm = trfrag(lp + 32768 + ((2 * dh + db) * 8 + ks) * 1024); acc[db] = MFMA32(af, bfm, acc[db]); }
    }
#pragma unroll
    for (int db = 0; db < 2; ++db)
#pragma unroll
        for (int r = 0; r < 16; ++r) kvT[base + (size_t)(32 * eb + crow(r, hi)) * 128 + 64 * dh + 32 * db + r32] = acc[db][r];
    __syncthreads();
}
__device__ __forceinline__ void scan_phase(const float* kvT, bf16_t* spT) {
    int tid_ = threadIdx.x; asm volatile("" : "+v"(tid_));
    const int gtid = blockIdx.x * NTHREADS + tid_, gsz = gridDim.x * NTHREADS;
    for (int idx = gtid; idx < 16 * 8192; idx += gsz) {
        const int bh = idx >> 13, e2 = (idx & 8191) * 2; const float gc = __builtin_amdgcn_exp2f(128.f * __builtin_amdgcn_logf(1.f - __builtin_amdgcn_exp2f(-5.f - (float)(bh & 3))));
        const size_t off0 = ((size_t)(bh * 64) << 14) + e2;
        float2 kvv[63];
#pragma unroll
        for (int n = 0; n < 63; ++n) kvv[n] = *(const float2*)(kvT + off0 + ((size_t)n << 14));
        float s0 = 0.f, s1 = 0.f;
#pragma unroll
        for (int n = 0; n < 64; ++n) { *(unsigned*)(spT + off0 + ((size_t)n << 14)) = cvtpk(s0, s1);
            if (n < 63) { s0 = gc * s0 + kvv[n].x; s1 = gc * s1 + kvv[n].y; } }
    }
}
__device__ __forceinline__ void out_unit(const bf16_t* qr, const bf16_t* kr, const bf16_t* vr, const bf16_t* spT, const bf16_t* sg, const float* gng, const float* gnb, bf16_t* mix, int unit, unsigned char* lds, NLAS unsigned char* lds3) {
    int tid_ = threadIdx.x; asm volatile("" : "+v"(tid_));
    const int tid = tid_, lane = tid & 63, wid = __builtin_amdgcn_readfirstlane(tid >> 6), r32 = lane & 31, hi = lane >> 5;
    const int bh = unit >> 6, n = unit & 63, h = bh & 3, b = bh >> 2; const float l2g = __builtin_amdgcn_logf(1.f - __builtin_amdgcn_exp2f(-5.f - (float)h));
    const size_t base = (size_t)unit * 16384;
    constexpr int LQ = 0, LK = 32768, LV = 65536, LS = 98304;
#pragma unroll
    for (int q = 0; q < 4; ++q) { const int c = tid + 512 * q, j = c >> 4, ch = c & 15;
        *(u32x4*)(lds + LQ + ch * 2048 + j * 16) = *(const u32x4*)(qr + base + (size_t)c * 8);
        *(u32x4*)(lds + LK + ch * 2048 + j * 16) = *(const u32x4*)(kr + base + (size_t)c * 8);
        *(u32x4*)(lds + LV + timg(j, ch * 8)) = *(const u32x4*)(vr + base + (size_t)c * 8);
        *(u32x4*)(lds + LS + ch * 2048 + j * 16) = *(const u32x4*)(spT + base + (size_t)c * 8); }
    __syncthreads();
    const int rb = wid >> 1, eh = wid & 1;
    const lds_cptr l3 = (lds_cptr)lds3;
    const lds_cptr vlp = l3 + LV + ((lane >> 4) & 1) * 32 + (lane & 3) * 8 + (4 * hi + ((lane & 15) >> 2)) * 64;
    bf16x8 qf[8];
#pragma unroll
    for (int ks = 0; ks < 8; ++ks) qf[ks] = *(const NLAS bf16x8*)(l3 + LQ + (2 * ks + hi) * 2048 + (32 * rb + r32) * 16);
    f32x16 acc[2];
#pragma unroll
    for (int i = 0; i < 16; ++i) { acc[0][i] = 0.f; acc[1][i] = 0.f; }
#pragma unroll
    for (int ks = 0; ks < 8; ++ks)
#pragma unroll
        for (int eb = 0; eb < 2; ++eb) { const bf16x8 sf = *(const NLAS bf16x8*)(l3 + LS + (2 * ks + hi) * 2048 + (64 * eh + 32 * eb + r32) * 16); acc[eb] = MFMA32(qf[ks], sf, acc[eb]); }
#pragma unroll
    for (int r = 0; r < 16; ++r) { const float xi = __builtin_amdgcn_exp2f((float)(32 * rb + crow(r, hi) + 1) * l2g); acc[0][r] *= xi; acc[1][r] *= xi; }
    for (int jb = 0; jb <= rb; ++jb) {
        f32x16 p;
#pragma unroll
        for (int i = 0; i < 16; ++i) p[i] = 0.f;
#pragma unroll
        for (int ks = 0; ks < 8; ++ks) { const bf16x8 kf = *(const NLAS bf16x8*)(l3 + LK + (2 * ks + hi) * 2048 + (32 * jb + r32) * 16); p = MFMA32(kf, qf[ks], p); }
        const int irow = 32 * rb + r32;
#pragma unroll
        for (int r = 0; r < 16; ++r) { const int dl = irow - (32 * jb + crow(r, hi)); p[r] = (dl >= 0) ? p[r] * __builtin_amdgcn_exp2f((float)dl * l2g) : 0.f; }
        u32x4 pw[2];
        pw[0] = (u32x4){cvtpk(p[0], p[1]), cvtpk(p[2], p[3]), cvtpk(p[4], p[5]), cvtpk(p[6], p[7])};
        pw[1] = (u32x4){cvtpk(p[8], p[9]), cvtpk(p[10], p[11]), cvtpk(p[12], p[13]), cvtpk(p[14], p[15])};
#pragma unroll
        for (int eb = 0; eb < 2; ++eb)
#pragma unroll
            for (int k2 = 0; k2 < 2; ++k2) { const bf16x8 vf = trfrag(vlp + ((2 * eh + eb) * 8 + 2 * jb + k2) * 1024); acc[eb] = MFMA32(__builtin_bit_cast(bf16x8, pw[k2]), vf, acc[eb]); }
    }
    __syncthreads();
    float* ost = (float*)lds;
#pragma unroll
    for (int eb = 0; eb < 2; ++eb)
#pragma unroll
        for (int r = 0; r < 16; ++r) ost[(32 * rb + crow(r, hi)) * 128 + 64 * eh + 32 * eb + r32] = acc[eb][r];
    __syncthreads();
    {
        const int i = tid >> 2, q4 = tid & 3;
        f32x4 v[8];
#pragma unroll
        for (int k = 0; k < 8; ++k) v[k] = *(const f32x4*)(ost + i * 128 + 32 * q4 + 4 * k);
        float s1 = 0.f;
#pragma unroll
        for (int k = 0; k < 8; ++k) s1 += hsum4(v[k]);
        s1 += __shfl_xor(s1, 1); s1 += __shfl_xor(s1, 2);
        const float mu = s1 * (1.f / 128.f); float s2 = 0.f;
#pragma unroll
        for (int k = 0; k < 8; ++k) { v[k] = v[k] - mu; s2 += hsum4(v[k] * v[k]); }
        s2 += __shfl_xor(s2, 1); s2 += __shfl_xor(s2, 2);
        const float rstd = rsqrtf(s2 * (1.f / 128.f) + LN_EPS);
        const size_t token = (size_t)b * SEQ + n * 128 + i; const int e0 = h * 128 + 32 * q4;
#pragma unroll
        for (int k2 = 0; k2 < 4; ++k2) {
            const u32x4 gw = *(const u32x4*)(sg + token * 512 + e0 + 8 * k2);
            const f32x4 o0 = v[2 * k2] * rstd * *(const f32x4*)(gng + e0 + 8 * k2) + *(const f32x4*)(gnb + e0 + 8 * k2);
            const f32x4 o1 = v[2 * k2 + 1] * rstd * *(const f32x4*)(gng + e0 + 8 * k2 + 4) + *(const f32x4*)(gnb + e0 + 8 * k2 + 4);
            *(u32x4*)(mix + token * 1024 + 512 + e0 + 8 * k2) = pack8(o0 * (f32x4){bflo(gw.x), bfhi(gw.x), bflo(gw.y), bfhi(gw.y)}, o1 * (f32x4){bflo(gw.z), bfhi(gw.z), bflo(gw.w), bfhi(gw.w)});
        }
    }
    __syncthreads();
}
}

__device__ __forceinline__ void final_ln_phase(float* yf, const float* st, const float* lg, const float* lb) {
    int tid_ = threadIdx.x; asm volatile("" : "+v"(tid_));
    const int lane = tid_ & 63; const int gw = blockIdx.x * 8 + (tid_ >> 6), NGW = gridDim.x * 8;
    f32x4 g[4], bb[4];
#pragma unroll
    for (int j = 0; j < 4; ++j) { g[j] = *(const f32x4*)(lg + 256 * j + 4 * lane); bb[j] = *(const f32x4*)(lb + 256 * j + 4 * lane); }
    for (int row = gw; row < M; row += NGW) {
        float mu, rs; row_stats(st, row, mu, rs);
        f32x4* p = (f32x4*)(yf + (size_t)row * DM) + lane;
#pragma unroll
        for (int j = 0; j < 4; ++j) { const f32x4 v = p[64 * j]; p[64 * j] = (v - mu) * rs * g[j] + bb[j]; }
    }
}

#define XB_TMO      128
#define XB_XCNT(j)  (256  + 64 * (j))
#define XB_XSUB(j)  (1280 + 64 * (j))
#define XB_XGEN(j)  (2304 + 64 * (j))
#define XB_TOP      3328
#define XB_TOPGEN   3392
#define XCD_BAR_WORDS 3456
#define XB_SPIN_CAP (1u << 18)

__device__ __forceinline__ unsigned xb_ld(unsigned* p)              { return __hip_atomic_load(p, __ATOMIC_RELAXED, __HIP_MEMORY_SCOPE_AGENT); }
__device__ __forceinline__ unsigned xb_add(unsigned* p, unsigned v) { return __hip_atomic_fetch_add(p, v, __ATOMIC_RELAXED, __HIP_MEMORY_SCOPE_AGENT); }
__device__ __forceinline__ unsigned xb_xcc_id() { return (unsigned)__builtin_amdgcn_s_getreg((3 << 11) | 20) & 0xFu; }
#define XB_SPIN(cond, bar) do { unsigned _sp = 0; while (cond) { __builtin_amdgcn_s_sleep(1); \
    if ((++_sp & 255u) == 0u) { if (xb_ld(&(bar)[XB_TMO])) break; if (_sp > XB_SPIN_CAP) { atomicAdd(&(bar)[XB_TMO], 1u); break; } } } } while (0)

struct XcdBarrier {
    unsigned* bar; unsigned x;
    volatile PG8_LAS unsigned* st;
};

__device__ __forceinline__ XcdBarrier xcd_barrier_post(unsigned* bar, volatile PG8_LAS unsigned* st) {
    XcdBarrier b; b.bar = bar; b.x = xb_xcc_id(); b.st = st;
    if (threadIdx.x == 0) (void)xb_add(&bar[XB_XCNT(b.x)], 1u);
    return b;
}
__device__ __forceinline__ void xcd_barrier_complete(unsigned* bar, unsigned x, unsigned& nloc, unsigned& nx) {
    const unsigned G = gridDim.x * gridDim.y * gridDim.z;
    unsigned sum, cnt, mine, sp = 0u;
    for (;;) {
        sum = 0u; cnt = 0u; mine = 0u;
#pragma unroll
        for (unsigned j = 0; j < 16; ++j) { const unsigned c = xb_ld(&bar[XB_XCNT(j)]); sum += c; cnt += (c > 0u) ? 1u : 0u; mine = (j == x) ? c : mine; }
        if (sum == G) break;
        __builtin_amdgcn_s_sleep(1);
        if ((++sp & 255u) == 0u) { if (xb_ld(&bar[XB_TMO])) break; if (sp > XB_SPIN_CAP) { atomicAdd(&bar[XB_TMO], 1u); break; } }
    }
    nloc = mine > 0u ? mine : 1u; nx = cnt > 0u ? cnt : 1u;
}

__device__ __forceinline__ void xcd_barrier(const XcdBarrier& b) {
    asm volatile("s_waitcnt vmcnt(0)" ::: "memory");
    __syncthreads();
    if (threadIdx.x == 0) {
        unsigned* bar = b.bar;
        __builtin_amdgcn_s_waitcnt(0);
        unsigned nloc = b.st[0], nx = b.st[1];
        if (nloc == 0u) { xcd_barrier_complete(bar, b.x, nloc, nx); b.st[0] = nloc; b.st[1] = nx; }
        const unsigned old = xb_add(&bar[XB_XSUB(b.x)], 1u);
        const unsigned gen = old / nloc;
        if (old + 1u == (gen + 1u) * nloc) {
            __builtin_amdgcn_fence(__ATOMIC_RELEASE, "agent");
            asm volatile("s_waitcnt vmcnt(0)" ::: "memory");
            const unsigned og = xb_add(&bar[XB_TOP], 1u);
            const unsigned tg = og / nx;
            if (og + 1u == (tg + 1u) * nx) xb_add(&bar[XB_TOPGEN], 1u);
            else XB_SPIN(xb_ld(&bar[XB_TOPGEN]) == tg, bar);
            __builtin_amdgcn_fence(__ATOMIC_ACQUIRE, "agent");
            xb_add(&bar[XB_XGEN(b.x)], 1u);
            asm volatile("s_waitcnt vmcnt(0)" ::: "memory");
        } else {
            XB_SPIN(xb_ld(&bar[XB_XGEN(b.x)]) == gen, bar);
            __builtin_amdgcn_fence(__ATOMIC_ACQUIRE, "agent");
            asm volatile("s_waitcnt vmcnt(0)" ::: "memory");
        }
    }
    __syncthreads();
}

__device__ __forceinline__ void panel_rendezvous(unsigned* cnt, unsigned* bar) {
    asm volatile("s_waitcnt vmcnt(0)" ::: "memory");
    __syncthreads();
    if (threadIdx.x == 0) {
        __builtin_amdgcn_fence(__ATOMIC_RELEASE, "agent"); asm volatile("s_waitcnt vmcnt(0)" ::: "memory");
        (void)xb_add(cnt, 1u);
        XB_SPIN(xb_ld(cnt) < 4u, bar);
        __builtin_amdgcn_fence(__ATOMIC_ACQUIRE, "agent"); asm volatile("s_waitcnt vmcnt(0)" ::: "memory");
    }
    __syncthreads();
}
struct EpiGateLn {
    static constexpr bool PERM = true, AFTER_DRAIN = false;
    float* out; const bf16_t* xb; const bf16_t* pe; float* st_out; const float* st_in; const float* lg; const float* lb; const float* c1; const float* c2; const float* lg4; const float* lb4; float2* tab; unsigned* cnt; unsigned* bar;
    __device__ __forceinline__ void operator()(f32x4 (&acc)[2][2][4][2], const Unit& u, int wr, int wc, int fr, int fq) const {
        const int colw = wc * 32 + 8 * fq, nb = u.pn * 256 + colw;
        u32x4 xn[2], pn_[2];
#pragma unroll
        for (int bj = 0; bj < 2; ++bj) { const size_t off0 = (size_t)(u.pm * 256 + wr * 64 + fr) * DM + nb + bj * 128; xn[bj] = *(const u32x4*)(xb + off0); pn_[bj] = *(const u32x4*)(pe + off0); }
        panel_stats(st_in, u.pm, tab);
#pragma unroll
        for (int ai = 0; ai < 2; ++ai)
#pragma unroll
            for (int m = 0; m < 4; ++m) {
                const int row = u.pm * 256 + ai * 128 + wr * 64 + m * 16 + fr;
                u32x4 xw[2], pw[2];
#pragma unroll
                for (int bj = 0; bj < 2; ++bj) { xw[bj] = xn[bj]; pw[bj] = pn_[bj]; }
                if (ai * 4 + m < 7) { const int r2 = ai * 4 + m + 1; const int row2 = u.pm * 256 + (r2 >> 2) * 128 + wr * 64 + (r2 & 3) * 16 + fr;
#pragma unroll
                    for (int bj = 0; bj < 2; ++bj) { const size_t off2 = (size_t)row2 * DM + nb + bj * 128; xn[bj] = *(const u32x4*)(xb + off2); pn_[bj] = *(const u32x4*)(pe + off2); } }
                __builtin_amdgcn_sched_barrier(0);
                const float2 mr = tab[ai * 128 + wr * 64 + m * 16 + fr]; const float mu = mr.x, rs = mr.y;
                float s = 0.f, q = 0.f;
#pragma unroll
                for (int bj = 0; bj < 2; ++bj) {
                    const int col = nb + bj * 128;
#pragma unroll
                    for (int n = 0; n < 2; ++n) {
                        const f32x4 k1 = *(const f32x4*)(c1 + col + 4 * n), k2 = *(const f32x4*)(c2 + col + 4 * n), gv = *(const f32x4*)(lg + col + 4 * n), bv = *(const f32x4*)(lb + col + 4 * n);
                        const f32x4 gt = sigmoid4((acc[ai][bj][m][n] - k1 * mu) * rs + k2);
                        const unsigned pa = n ? pw[bj].z : pw[bj].x, pb = n ? pw[bj].w : pw[bj].y, xa = n ? xw[bj].z : xw[bj].x, xc = n ? xw[bj].w : xw[bj].y;
                        const f32x4 e = (f32x4){bflo(pa), bfhi(pa), bflo(pb), bfhi(pb)} * gt;
                        const f32x4 x = ((f32x4){bflo(xa), bfhi(xa), bflo(xc), bfhi(xc)} - mu) * rs * gv + bv;
                        const f32x4 y = x * ALPHA + e;
                        acc[ai][bj][m][n] = y;
                        s += hsum4(y); q += hsum4(y * y);
                    }
                }
                s = xsum32(xsum16(s)); q = xsum32(xsum16(q));
                if (fq == 0) *(float2*)(st_out + (size_t)row * 32 + (u.pn * 4 + wc) * 2) = make_float2(s, q);
            }
        panel_rendezvous(cnt + 16 * u.pm, bar);
        panel_stats(st_out, u.pm, tab);
#pragma unroll
        for (int ai = 0; ai < 2; ++ai)
#pragma unroll
            for (int m = 0; m < 4; ++m) {
                const int row = u.pm * 256 + ai * 128 + wr * 64 + m * 16 + fr;
                const float2 mr = tab[ai * 128 + wr * 64 + m * 16 + fr];
#pragma unroll
                for (int bj = 0; bj < 2; ++bj) {
                    const int col = nb + bj * 128; const size_t off = (size_t)row * DM + col;
#pragma unroll
                    for (int n = 0; n < 2; ++n) *(f32x4*)(out + off + 4 * n) = (acc[ai][bj][m][n] - mr.x) * mr.y * *(const f32x4*)(lg4 + col + 4 * n) + *(const f32x4*)(lb4 + col + 4 * n);
                }
            }
    }
};

#ifndef PH_MASK
#define PH_MASK 0xFFFF
#endif
#define PH(k) ((PH_MASK >> (k)) & 1)
__global__ void __launch_bounds__(NTHREADS, 2) fwd_mega(Args a) {
    extern __shared__ __attribute__((aligned(16))) unsigned char lds[];
    PG8_LAS unsigned char* ldsp = (PG8_LAS unsigned char*)lds;
    const int G = gridDim.x, bid = blockIdx.x;
    unsigned char* ws = a.ws;
    bf16_t* wb = (bf16_t*)(ws + OFF_W);
    float* vec = (float*)(ws + OFF_VEC);
    float* st1 = (float*)(ws + OFF_STATS); float* st2 = st1 + (size_t)M * 32; float* st3 = st2 + (size_t)M * 32; float* st4 = st3 + (size_t)M * 32;
    bf16_t* yb = (bf16_t*)(ws + OFF_YB); bf16_t* pb = (bf16_t*)(ws + OFF_PB); bf16_t* pe = (bf16_t*)(ws + OFF_PE); bf16_t* hb = (bf16_t*)(ws + OFF_HB);
    bf16_t* qn = hb + HB_QN; bf16_t* kvb = hb + HB_KV; bf16_t* qr = hb + HB_QR; bf16_t* kr = hb + HB_KR; bf16_t* vr = hb + HB_VR;
    bf16_t* sg = (bf16_t*)(ws + OFF_SG); float* gates = (float*)(ws + OFF_GATES); float* kvst = (float*)(ws + OFF_KVST); bf16_t* mix = (bf16_t*)(ws + OFF_KVST);
    bf16_t* sprev = (bf16_t*)a.out;
    bf16_t* ch = (bf16_t*)(ws + OFF_CH); bf16_t* kcmp = (bf16_t*)(ws + OFF_KCMP);
    const float* lng = a.in[13]; const float* lnb = a.in[14];
    float* yf = a.out;
    float2* ptab = (float2*)(lds + 131072);
    volatile PG8_LAS unsigned* misc = (volatile PG8_LAS unsigned*)(ldsp + 140000);
    if (threadIdx.x < 4) misc[threadIdx.x] = 0u;
    __syncthreads();
    XcdBarrier xbar = xcd_barrier_post((unsigned*)ws, misc);
#define GRID_BAR() xcd_barrier(xbar)

    if (PH(0)) prep_phase(a, lds);
    GRID_BAR();
    reduce_vec_phase(a, 0, NINP, true);
    if (PH(1)) { pg8::Gemm g{yb, wb + W_13A, M, 5632, 1024, 1024}; pg8::StaticOrder S; S.init(M, 5632, G, bid);
      EpiSwigluT<false> E{hb, nullptr, nullptr, nullptr, ptab};
      pg8::gemm_phase<EpiSwigluT<false>, pg8::StaticOrder, true, true>(ldsp, g, S, E); }
    GRID_BAR();
    if (PH(2)) { pg8::Gemm g{hb, wb + W_2A, M, 1024, DFF, HP}; pg8::StaticOrder S; S.init(M, 1024, G, bid);
      EpiRes<false> E{yb, yb, st1, nullptr, nullptr, nullptr, 0.5f, ptab};
      pg8::gemm_phase<EpiRes<false>, pg8::StaticOrder, true, true>(ldsp, g, S, E); }
    GRID_BAR();
    if (PH(3)) { pg8::Gemm g{yb, wb + W_IN, M, NINP, 1024, 1024}; pg8::StaticOrder S; S.init(M, NINP, G, bid);
      EpiInProj E{st1, vec + V_C1, vec + V_C2, qn, kvb, qr, kr, vr, sg, gates, ptab};
      pg8::gemm_phase<EpiInProj, pg8::StaticOrder, true, true>(ldsp, g, S, E); }
    GRID_BAR();
    if (PH(4)) { const int j = bid >> 4;
      pg8::Gemm g{kvb + (size_t)(j & 1) * KVSZ, wb + ((j & 1) ? W_C1V : W_C1K), 4096, 256, 2048, 1024}; OneUnit S{bid & 15, bid < 32};
      EpiCmp1 E{ch + (size_t)(j & 1) * 4096 * 256, vec + V_CB + (j & 1) * 256};
      pg8::gemm_phase<EpiCmp1, OneUnit, false, true>(ldsp, g, S, E); }
    __syncthreads();
    { const bool side = (G > 64) ? (bid >= 32) : true; const int Gs = (G > 64) ? G - 32 : G, cs = (G > 64) ? bid - 32 : bid;
      if (side) {
          for (int u = cs; u < 1024; u += Gs) ret::kv_unit(kr, vr, kvst, u, lds, ldsp);
          int kple = PLE; asm volatile("" : "+s"(kple)); pg8::Gemm g{pb, wb + W_PLE, M, 1024, kple, kple}; pg8::StaticOrder S; S.init(M, 1024, Gs, cs);
          EpiPlain E{pe};
          pg8::gemm_phase<EpiPlain, pg8::StaticOrder, true, true>(ldsp, g, S, E);
      } }
    GRID_BAR();
    if (PH(6)) { const int j = bid >> 4;
      int kc2 = 256; asm volatile("" : "+s"(kc2)); pg8::Gemm g{ch + (size_t)(j & 1) * 4096 * 256, wb + ((j & 1) ? W_C2V : W_C2K), 4096, 256, kc2, kc2}; OneUnit S{bid & 15, bid < 32};
      EpiCmp2 E{kcmp + (size_t)(j & 1) * KCMP_J};
      pg8::gemm_phase<EpiCmp2, OneUnit, false, true>(ldsp, g, S, E); }
    if (PH(7)) ret::scan_phase(kvst, sprev);
    { int tw_ = threadIdx.x; asm volatile("" : "+v"(tw_));
      if (G > 64) { if (bid >= 32) prep_weights(a, lds, true, (bid - 32) * 8 + (tw_ >> 6), (G - 32) * 8); } else prep_weights(a, lds, true, bid * 8 + (tw_ >> 6), G * 8); }
    GRID_BAR();
    if (PH(8)) { const nsa::Ptrs NP{qn, kvb, kcmp, gates, mix};
      if (G == 256) { const int bgx = bid & 7, pr = bid >> 3;
#pragma nounroll
          for (int k = 0; k < 4; ++k) { const int itile = (k == 0) ? 127 - pr : (k == 1) ? 95 - pr : (k == 2) ? pr + 32 : pr; nsa::unit(NP, bgx, itile, lds, ldsp); } }
      else for (int u = bid; u < 1024; u += G) nsa::unit(NP, u & 7, u >> 3, lds, ldsp); }
    reduce_vec_phase(a, NINP, NCV, false);
    if (PH(9)) for (int u = bid; u < 1024; u += G) ret::out_unit(qr, kr, vr, sprev, sg, a.in[8], a.in[9], mix, u, lds, ldsp);
    GRID_BAR();
    if (PH(10)) { pg8::Gemm g{mix, wb + W_OUT, M, 1024, 1024, 1024}; pg8::StaticOrder S; S.init(M, 1024, G, bid);
      EpiRes<true> E{yb, yb, st2, st1, lng, lnb, 1.0f, ptab};
      pg8::gemm_phase<EpiRes<true>, pg8::StaticOrder, true, true>(ldsp, g, S, E); }
    GRID_BAR();
    if (PH(11)) { pg8::Gemm g{yb, wb + W_13B, M, 5632, 1024, 1024}; pg8::StaticOrder S; S.init(M, 5632, G, bid);
      EpiSwigluT<true> E{hb, st2, vec + V_C1 + NINP, vec + V_C2 + NINP, ptab};
      pg8::gemm_phase<EpiSwigluT<true>, pg8::StaticOrder, true, true>(ldsp, g, S, E); }
    GRID_BAR();
    if (PH(12)) { pg8::Gemm g{hb, wb + W_2B, M, 1024, DFF, HP}; pg8::StaticOrder S; S.init(M, 1024, G, bid);
      EpiRes<true> E{yb, yb, st3, st2, lng + 1024, lnb + 1024, 0.5f, ptab};
      pg8::gemm_phase<EpiRes<true>, pg8::StaticOrder, true, true>(ldsp, g, S, E); }
    GRID_BAR();
    if (G == 256) {
        pg8::Gemm g{yb, wb + W_PG, M, 1024, 1024, 1024}; pg8::StaticOrder S; S.init(M, 1024, G, bid);
        EpiGateLn E{yf, yb, pe, st4, st3, lng + 2048, lnb + 2048, vec + V_C1 + NINP + 5632, vec + V_C2 + NINP + 5632, lng + 3072, lnb + 3072, ptab, (unsigned*)(ws + 16384), (unsigned*)ws};
        pg8::gemm_phase<EpiGateLn, pg8::StaticOrder, true, true>(ldsp, g, S, E);
    } else {
        { pg8::Gemm g{yb, wb + W_PG, M, 1024, 1024, 1024}; pg8::StaticOrder S; S.init(M, 1024, G, bid);
          EpiGate E{yf, yb, pe, st4, st3, lng + 2048, lnb + 2048, vec + V_C1 + NINP + 5632, vec + V_C2 + NINP + 5632, ptab};
          pg8::gemm_phase<EpiGate, pg8::StaticOrder, true, true>(ldsp, g, S, E); }
        GRID_BAR();
        final_ln_phase(yf, st4, lng + 3072, lnb + 3072);
    }
}

extern "C" void kernel_launch(void* const* d_in, const int* in_sizes, int n_in, void* d_out, int out_size, void* d_ws, size_t ws_size, hipStream_t stream) {
    static int grid_blocks = 0;
    if (!grid_blocks) {
        int dev = 0, cus = 0, per_cu = 0;
        (void)hipGetDevice(&dev);
        (void)hipDeviceGetAttribute(&cus, hipDeviceAttributeMultiprocessorCount, dev);
        (void)hipFuncSetAttribute((const void*)fwd_mega, hipFuncAttributeMaxDynamicSharedMemorySize, LDS_BYTES);
        (void)hipOccupancyMaxActiveBlocksPerMultiprocessor(&per_cu, (const void*)fwd_mega, NTHREADS, LDS_BYTES);
        if (per_cu < 1) fprintf(stderr, "kernel_launch: occupancy query reports %d blocks per CU\n", per_cu);
        if (ws_size < WS_NEED || n_in != 15 || out_size != M * DM) fprintf(stderr, "kernel_launch: unexpected sizes: ws %zu (need %zu), n_in %d, out %d\n", ws_size, (size_t)WS_NEED, n_in, out_size);
        grid_blocks = cus;
    }
    (void)hipMemsetAsync(d_ws, 0, 32768, stream);
    Args a{};
    for (int i = 0; i < 15; ++i) a.in[i] = (const float*)d_in[i];
    a.out = (float*)d_out; a.ws = (unsigned char*)d_ws;
    void* args[] = {&a};
    const hipError_t e = hipLaunchCooperativeKernel((const void*)fwd_mega, dim3(grid_blocks), dim3(NTHREADS), args, LDS_BYTES, stream);
    if (e != hipSuccess) fprintf(stderr, "kernel_launch: cooperative launch failed: %s (grid %d)\n", hipGetErrorString(e), grid_blocks);
}
```
